# Optimizing an MI355X kernel written in HIP

```python
import jax, jax.numpy as jnp
from jax import lax
import numpy as np


D_MODEL = 1024
BATCH = 8
SEQ = 4096
DEPTH = 1

A_HEADS = 8
A_HEAD_DIM = 64
A_WIDTH = A_HEADS * A_HEAD_DIM
MOBA_BLOCK = 256
MOBA_TOPK = 3
MOBA_QCHUNK = 128
M_HEADS = 4
M_HEAD_DIM = 128
M_WIDTH = M_HEADS * M_HEAD_DIM
M_CONV = 4
M_CHUNK = 64
N_EXPERTS = 32
TOP_K = 4
D_FF = 1024
SWIGLU_LIMIT = 7.0
SWIGLU_ALPHA = 1.702
MOE_BLOCK = 256
ROPE_THETA = 10000.0
EPS = 1e-6
NEG = -1e30
IN_SIZES = (A_WIDTH, A_WIDTH, A_WIDTH, M_WIDTH, M_WIDTH, M_WIDTH, M_WIDTH, M_HEADS, M_HEADS, D_MODEL, D_MODEL)
IN_SPLITS = tuple(sum(IN_SIZES[:i + 1]) for i in range(len(IN_SIZES) - 1))
IN_COLS = sum(IN_SIZES)

kernel_name = 'hybrid_moba_mlstm_moe_block'


def rmsnorm(x, w):
    xf = x.astype(jnp.float32)
    y = xf * lax.rsqrt(jnp.mean(xf * xf, axis=-1, keepdims=True) + EPS)
    return (y * w.astype(jnp.float32)).astype(x.dtype)


def rope(t):
    s, dh = t.shape[-2], t.shape[-1]
    inv = ROPE_THETA ** (-jnp.arange(0, dh, 2, dtype=jnp.float32) / dh)
    ang = jnp.arange(s, dtype=jnp.float32)[:, None] * inv[None, :]
    cos = jnp.concatenate([jnp.cos(ang), jnp.cos(ang)], axis=-1)
    sin = jnp.concatenate([jnp.sin(ang), jnp.sin(ang)], axis=-1)
    tf = t.astype(jnp.float32)
    rot = jnp.concatenate([-tf[..., dh // 2:], tf[..., :dh // 2]], axis=-1)
    return (tf * cos + rot * sin).astype(t.dtype)


def causal_dwconv(u, w, b):
    width, ch = w.shape
    y = lax.conv_general_dilated(u, w[:, None, :].astype(u.dtype), window_strides=(1,),
                                 padding=[(width - 1, 0)],
                                 dimension_numbers=('NWC', 'WIO', 'NWC'),
                                 feature_group_count=ch)
    return y + b.astype(u.dtype)


def moba_attention(q, k, v):
    bsz, nh, s, dh = q.shape
    nb = -(-s // MOBA_BLOCK)
    pad = nb * MOBA_BLOCK - s
    kb = jnp.pad(k, ((0, 0), (0, 0), (0, pad), (0, 0))).reshape(bsz, nh, nb, MOBA_BLOCK, dh)
    vb = jnp.pad(v, ((0, 0), (0, 0), (0, pad), (0, 0))).reshape(bsz, nh, nb, MOBA_BLOCK, dh)
    k_mean = jnp.mean(kb.astype(jnp.float32), axis=3)
    q_blk = jnp.arange(s) // MOBA_BLOCK
    past = jnp.arange(nb)[None, :] < q_blk[:, None]
    gate = jnp.einsum('bhsd,bhnd->bhsn', q.astype(jnp.float32), k_mean)
    gate = jnp.where(past, gate, -jnp.inf)
    ksel = min(MOBA_TOPK, nb)
    _, sel = lax.top_k(gate, ksel)
    valid = jnp.arange(ksel)[None, :] < q_blk[:, None]
    nq = s // MOBA_QCHUNK
    qc = q.reshape(bsz, nh, nq, MOBA_QCHUNK, dh).transpose(0, 2, 1, 3, 4)
    selc = sel.reshape(bsz, nh, nq, MOBA_QCHUNK, ksel).transpose(0, 2, 1, 3, 4)
    validc = valid.reshape(nq, MOBA_QCHUNK, ksel)
    scale = dh ** -0.5
    gather_blocks = jax.vmap(lambda blocks, idx: blocks[idx])

    def per_batch(args):
        q_b, sel_b, kb_b, vb_b = args

        def per_chunk(cargs):
            c, q_c, sel_c, valid_c = cargs
            j = (c * MOBA_QCHUNK) // MOBA_BLOCK
            k_sel = gather_blocks(kb_b, sel_c)
            v_sel = gather_blocks(vb_b, sel_c)
            k_own = lax.dynamic_index_in_dim(kb_b, j, axis=1, keepdims=False)
            v_own = lax.dynamic_index_in_dim(vb_b, j, axis=1, keepdims=False)
            q_pos = c * MOBA_QCHUNK + jnp.arange(MOBA_QCHUNK)
            k_pos = j * MOBA_BLOCK + jnp.arange(MOBA_BLOCK)
            s_own = jnp.einsum('hqd,hkd->hqk', q_c, k_own).astype(jnp.float32) * scale
            s_own = jnp.where(k_pos[None, :] <= q_pos[:, None], s_own, NEG)
            s_sel = jnp.einsum('hqd,hqnkd->hqnk', q_c, k_sel).astype(jnp.float32) * scale
            s_sel = jnp.where(valid_c[None, :, :, None], s_sel, NEG)
            scores = jnp.concatenate([s_own, s_sel.reshape(nh, MOBA_QCHUNK, ksel * MOBA_BLOCK)], axis=-1)
            p = jax.nn.softmax(scores, axis=-1).astype(q_c.dtype)
            p_own = p[..., :MOBA_BLOCK]
            p_sel = p[..., MOBA_BLOCK:].reshape(nh, MOBA_QCHUNK, ksel, MOBA_BLOCK)
            return (jnp.einsum('hqk,hkd->hqd', p_own, v_own)
                    + jnp.einsum('hqnk,hqnkd->hqd', p_sel, v_sel))

        return lax.map(per_chunk, (jnp.arange(nq), q_b, sel_b, validc))

    out = lax.map(per_batch, (qc, selc, kb, vb))
    return out.transpose(0, 2, 1, 3, 4).reshape(bsz, nh, s, dh)


def mlstm_chunkwise(q, k, v, i_pre, f_pre):
    bsz, nh, s, dh = q.shape
    nc = s // M_CHUNK
    k = k * (dh ** -0.5)
    log_f = jax.nn.log_sigmoid(f_pre)

    def chunks(t):
        return jnp.moveaxis(t.reshape((bsz, nh, nc, M_CHUNK) + t.shape[3:]), 2, 0)

    causal = jnp.tril(jnp.ones((M_CHUNK, M_CHUNK), dtype=bool))

    def step(carry, xs):
        c_st, n_st, m_st = carry
        q_c, k_c, v_c, i_c, f_c = xs
        b = jnp.cumsum(f_c, axis=-1)
        d = b[..., :, None] - b[..., None, :] + i_c[..., None, :]
        d = jnp.where(causal, d, -jnp.inf)
        g = b + m_st[..., None]
        m_t = jnp.maximum(g, jnp.max(d, axis=-1))
        w_intra = jnp.exp(d - m_t[..., None])
        w_inter = jnp.exp(g - m_t)
        qk = jnp.einsum('bhtd,bhsd->bhts', q_c, k_c) * w_intra
        num = (w_inter[..., None] * jnp.einsum('bhvd,bhtd->bhtv', c_st, q_c)
               + jnp.einsum('bhts,bhsv->bhtv', qk, v_c))
        den = w_inter * jnp.einsum('bhd,bhtd->bht', n_st, q_c) + jnp.sum(qk, axis=-1)
        h = num / jnp.maximum(jnp.abs(den), jnp.exp(-m_t))[..., None]
        b_last = b[..., -1]
        log_w = b_last[..., None] - b + i_c
        m_new = jnp.maximum(b_last + m_st, jnp.max(log_w, axis=-1))
        w_k = jnp.exp(log_w - m_new[..., None])
        decay = jnp.exp(b_last + m_st - m_new)
        c_new = decay[..., None, None] * c_st + jnp.einsum('bhs,bhsv,bhsd->bhvd', w_k, v_c, k_c)
        n_new = decay[..., None] * n_st + jnp.einsum('bhs,bhsd->bhd', w_k, k_c)
        return (c_new, n_new, m_new), h

    init = (jnp.zeros((bsz, nh, dh, dh), jnp.float32),
            jnp.zeros((bsz, nh, dh), jnp.float32),
            jnp.zeros((bsz, nh), jnp.float32))
    _, hs = lax.scan(step, init, (chunks(q), chunks(k), chunks(v), chunks(i_pre), chunks(log_f)))
    return jnp.moveaxis(hs, 0, 2).reshape(bsz, nh, s, dh)


def token_mixer(xn, w_in, m_conv_w, m_conv_b, m_gate_bias, m_head_norm_w, w_branch, w_out):
    bsz, s, _ = xn.shape
    proj = xn @ w_in
    a_q, a_k, a_v, m_q, m_k, m_v, m_o, m_i, m_f, g_a, g_m = jnp.split(proj, IN_SPLITS, axis=-1)

    def heads(t, nh, dh):
        return t.reshape(bsz, s, nh, dh).transpose(0, 2, 1, 3)

    y_a = moba_attention(rope(heads(a_q, A_HEADS, A_HEAD_DIM)),
                         rope(heads(a_k, A_HEADS, A_HEAD_DIM)),
                         heads(a_v, A_HEADS, A_HEAD_DIM))
    y_a = y_a.transpose(0, 2, 1, 3).reshape(bsz, s, A_WIDTH)

    qk = jax.nn.silu(causal_dwconv(jnp.concatenate([m_q, m_k], axis=-1), m_conv_w, m_conv_b))
    m_q, m_k = qk[..., :M_WIDTH], qk[..., M_WIDTH:]
    gates = (jnp.concatenate([m_i, m_f], axis=-1) + m_gate_bias).astype(jnp.float32).transpose(0, 2, 1)
    h_m = mlstm_chunkwise(heads(m_q, M_HEADS, M_HEAD_DIM).astype(jnp.float32),
                          heads(m_k, M_HEADS, M_HEAD_DIM).astype(jnp.float32),
                          heads(m_v, M_HEADS, M_HEAD_DIM).astype(jnp.float32),
                          gates[:, :M_HEADS], gates[:, M_HEADS:])
    h_m = h_m * lax.rsqrt(jnp.mean(h_m * h_m, axis=-1, keepdims=True) + EPS)
    h_m = h_m.transpose(0, 2, 1, 3).reshape(bsz, s, M_WIDTH)
    y_m = (h_m * m_head_norm_w.astype(jnp.float32)).astype(xn.dtype) * jax.nn.sigmoid(m_o)

    p_a = y_a @ w_branch[:A_WIDTH]
    p_m = y_m @ w_branch[A_WIDTH:]
    merged = jax.nn.sigmoid(g_a) * p_a + jax.nn.sigmoid(g_m) * p_m
    return merged @ w_out


def moe_ffn(xn, w_router, b_router, w_mlp1, b_mlp1, w_mlp2, b_mlp2):
    bsz, s, d = xn.shape
    n_tok = bsz * s
    xt = xn.reshape(n_tok, d)
    logits = (xt @ w_router + b_router).astype(jnp.float32)
    top_val, top_idx = lax.top_k(logits, TOP_K)
    gate = jax.nn.softmax(top_val, axis=-1)
    n_asg = n_tok * TOP_K
    e_flat = top_idx.reshape(n_asg).astype(jnp.int32)
    tok_flat = jnp.arange(n_asg, dtype=jnp.int32) // TOP_K
    counts = jnp.bincount(e_flat, length=N_EXPERTS).astype(jnp.int32)
    padded = (counts + MOE_BLOCK - 1) // MOE_BLOCK * MOE_BLOCK
    pad_end = jnp.cumsum(padded)
    pad_start = pad_end - padded
    start = jnp.cumsum(counts) - counts
    order = jnp.argsort(e_flat)
    e_sorted = e_flat[order]
    dest_sorted = (pad_start[e_sorted] + jnp.arange(n_asg, dtype=jnp.int32) - start[e_sorted]).astype(jnp.int32)
    dest = jnp.zeros((n_asg,), jnp.int32).at[order].set(dest_sorted)
    n_blk = -(-n_asg // MOE_BLOCK) + N_EXPERTS
    n_rows = n_blk * MOE_BLOCK
    row_tok = jnp.full((n_rows,), n_tok, jnp.int32).at[dest].set(tok_flat)
    x_rows = jnp.concatenate([xt, jnp.zeros((1, d), xt.dtype)], axis=0)[row_tok].reshape(n_blk, MOE_BLOCK, d)
    blk_expert = jnp.minimum(jnp.searchsorted(pad_end, jnp.arange(n_blk, dtype=jnp.int32) * MOE_BLOCK,
                                              side='right'), N_EXPERTS - 1)

    def expert_block(args):
        xb, e = args
        hdn = xb @ w_mlp1[e] + b_mlp1[e]
        glu = jnp.minimum(hdn[:, :D_FF], SWIGLU_LIMIT)
        lin = jnp.clip(hdn[:, D_FF:], -SWIGLU_LIMIT, SWIGLU_LIMIT)
        act = glu * jax.nn.sigmoid(SWIGLU_ALPHA * glu) * (lin + 1.0)
        return act @ w_mlp2[e] + b_mlp2[e]

    y_rows = lax.map(expert_block, (x_rows, blk_expert)).reshape(n_rows, d)
    y = y_rows[dest].reshape(n_tok, TOP_K, d)
    return jnp.einsum('tk,tkd->td', gate.astype(y.dtype), y).reshape(bsz, s, d)


def setup_inputs(seed: int = 0) -> dict:
    key = jax.random.key(seed)
    ks = jax.random.split(key, 18)
    f32 = jnp.float32
    L = DEPTH

    def nrm(k, shape, scale):
        return jax.random.normal(k, shape, f32) * scale

    return {
        'x': nrm(ks[0], (BATCH, SEQ, D_MODEL), 1.0),
        'norm_mix_w': 1.0 + nrm(ks[1], (L, D_MODEL), 0.02),
        'w_in': nrm(ks[2], (L, D_MODEL, IN_COLS), D_MODEL ** -0.5),
        'm_conv_w': nrm(ks[3], (L, M_CONV, 2 * M_WIDTH), M_CONV ** -0.5),
        'm_conv_b': nrm(ks[4], (L, 2 * M_WIDTH), 0.01),
        'm_gate_bias': jnp.concatenate([nrm(ks[5], (L, M_HEADS), 0.1),
                                        3.0 + 3.0 * jax.random.uniform(ks[6], (L, M_HEADS), f32)], axis=-1),
        'm_head_norm_w': 1.0 + nrm(ks[7], (L, M_WIDTH), 0.02),
        'w_branch': nrm(ks[8], (L, A_WIDTH + M_WIDTH, D_MODEL), A_WIDTH ** -0.5),
        'w_out': nrm(ks[9], (L, D_MODEL, D_MODEL), D_MODEL ** -0.5),
        'norm_ffn_w': 1.0 + nrm(ks[10], (L, D_MODEL), 0.02),
        'w_router': nrm(ks[11], (L, D_MODEL, N_EXPERTS), D_MODEL ** -0.5),
        'b_router': nrm(ks[12], (L, N_EXPERTS), 0.01),
        'w_mlp1': nrm(ks[13], (L, N_EXPERTS, D_MODEL, 2 * D_FF), D_MODEL ** -0.5),
        'b_mlp1': nrm(ks[14], (L, N_EXPERTS, 2 * D_FF), 0.01),
        'w_mlp2': nrm(ks[15], (L, N_EXPERTS, D_FF, D_MODEL), D_FF ** -0.5),
        'b_mlp2': nrm(ks[16], (L, N_EXPERTS, D_MODEL), 0.01),
        'norm_final_w': 1.0 + nrm(ks[17], (D_MODEL,), 0.02),
    }


def reference(x, norm_mix_w, w_in, m_conv_w, m_conv_b, m_gate_bias, m_head_norm_w, w_branch, w_out,
              norm_ffn_w, w_router, b_router, w_mlp1, b_mlp1, w_mlp2, b_mlp2, norm_final_w):
    h = x
    for l in range(DEPTH):
        h = h + token_mixer(rmsnorm(h, norm_mix_w[l]), w_in[l], m_conv_w[l], m_conv_b[l],
                            m_gate_bias[l], m_head_norm_w[l], w_branch[l], w_out[l])
        h = h + moe_ffn(rmsnorm(h, norm_ffn_w[l]), w_router[l], b_router[l],
                        w_mlp1[l], b_mlp1[l], w_mlp2[l], b_mlp2[l])
    return rmsnorm(h, norm_final_w)
```

```cpp
#include <hip/hip_runtime.h>
#include <stdint.h>
#include <math.h>
#include <cstdio>

typedef unsigned short bf16_t;
typedef short bf16x8 __attribute__((ext_vector_type(8)));
typedef float f32x16 __attribute__((ext_vector_type(16)));

constexpr int T_TOK = 32768, DM = 1024, SEQ = 4096, NB = 8;
constexpr int IN_COLS = 5640;
constexpr float EPS = 1e-6f;
constexpr float C2 = 0.125f * 1.4426950408889634f;
constexpr size_t MiB = 1u << 20;
constexpr size_t WS_CTL = 0, WS_ROPE = 8, WS_KMEAN = 9, WS_ASGE = 10, WS_ASGP = 11, WS_ASGG = 12, WS_ROWTOK = 13, WS_LIST = 14, WS_GATES = 18;
constexpr size_t WS_WIN = 20, WS_WB = 32, WS_WO = 34, WS_W1 = 36, WS_W2 = 164, WS_H = 228, WS_XN = 356;
constexpr size_t WS_Q = 420, WS_K = 452, WS_V = 484, WS_MQ = 516, WS_MK = 548, WS_MV = 580, WS_MO = 612, WS_GA = 644, WS_GM = 708;
constexpr size_t WS_QRAW = 772, WS_KRAW = 836, WS_HRAW = 772, WS_MERGED = 836, WS_YA = 900, WS_YM = 932;
constexpr size_t WS_ACT = 420, WS_YROWS = 692, WS_END = 964;
constexpr int MAXROWS = 131072 + 32 * 256;
constexpr int CW_CNT = 0, CW_NROWS = 64, CW_PSTART = 128, CW_TILEE = 256;

__device__ __forceinline__ unsigned short f2bf(float f) { unsigned u = __float_as_uint(f); u += 0x7fffu + ((u >> 16) & 1u); return (unsigned short)(u >> 16); }
__device__ __forceinline__ float bf2f(unsigned short b) { return __uint_as_float(((unsigned)b) << 16); }
__device__ __forceinline__ float wave_sum(float v) {
#pragma unroll
    for (int o = 32; o > 0; o >>= 1) v += __shfl_xor(v, o);
    return v; }
__device__ __forceinline__ float wave_max(float v) {
#pragma unroll
    for (int o = 32; o > 0; o >>= 1) v = fmaxf(v, __shfl_xor(v, o));
    return v; }
__device__ __forceinline__ float sigm(float x) { return 1.f / (1.f + __expf(-x)); }

__global__ void k_transpose_bf16(const float* src, bf16_t* dst, int K, int N, int ld, size_t sstride, size_t dstride) {
    __shared__ float tile[32][33];
    src += blockIdx.z * sstride; dst += blockIdx.z * dstride;
    const int n0 = blockIdx.x * 32, k0 = blockIdx.y * 32, tx = threadIdx.x, ty = threadIdx.y;
    for (int i = ty; i < 32; i += 8) { const int k = k0 + i, n = n0 + tx; tile[i][tx] = (n < N) ? src[(size_t)k * ld + n] : 0.f; }
    __syncthreads();
    for (int i = ty; i < 32; i += 8) { const int n = n0 + i, k = k0 + tx; if (n < N) dst[(size_t)n * K + k] = f2bf(tile[tx][i]); }
}
__global__ void k_ropetab(float2* tab) {
    const int idx = blockIdx.x * blockDim.x + threadIdx.x; if (idx >= SEQ * 32) return;
    const int pos = idx >> 5, i = idx & 31;
    const float inv = (float)pow(10000.0, -(double)(2 * i) / 64.0);
    const float ang = (float)pos * inv;
    tab[idx] = make_float2((float)cos((double)ang), (float)sin((double)ang));
}
__global__ __launch_bounds__(256) void k_rms1(const float* x, const float* wn, const float* w_in, const float* gbias, bf16_t* xn, float* gates) {
    const int row = blockIdx.x * 4 + (threadIdx.x >> 6), lane = threadIdx.x & 63;
    const float4* xr = (const float4*)(x + (size_t)row * DM);
    float4 v[4]; float ss = 0.f;
#pragma unroll
    for (int j = 0; j < 4; ++j) { v[j] = xr[lane + 64 * j]; ss += v[j].x * v[j].x + v[j].y * v[j].y + v[j].z * v[j].z + v[j].w * v[j].w; }
    ss = wave_sum(ss); const float rs = rsqrtf(ss * (1.f / DM) + EPS);
    float g[8];
#pragma unroll
    for (int e = 0; e < 8; ++e) g[e] = 0.f;
#pragma unroll
    for (int j = 0; j < 4; ++j) {
        const float4 w = ((const float4*)wn)[lane + 64 * j];
        float y[4] = {v[j].x * rs * w.x, v[j].y * rs * w.y, v[j].z * rs * w.z, v[j].w * rs * w.w};
        const int k0 = 4 * (lane + 64 * j);
        ushort4 o; o.x = f2bf(y[0]); o.y = f2bf(y[1]); o.z = f2bf(y[2]); o.w = f2bf(y[3]);
        *(ushort4*)(xn + (size_t)row * DM + k0) = o;
#pragma unroll
        for (int c = 0; c < 4; ++c) {
            const float4* wg = (const float4*)(w_in + (size_t)(k0 + c) * IN_COLS + 3584);
            const float4 a = wg[0], b = wg[1];
            g[0] += y[c] * a.x; g[1] += y[c] * a.y; g[2] += y[c] * a.z; g[3] += y[c] * a.w;
            g[4] += y[c] * b.x; g[5] += y[c] * b.y; g[6] += y[c] * b.z; g[7] += y[c] * b.w;
        }
    }
#pragma unroll
    for (int e = 0; e < 8; ++e) { const float s = wave_sum(g[e]); if (lane == 0) gates[(size_t)row * 8 + e] = s + gbias[e]; }
}
struct GArgs { const bf16_t *A0, *B0, *A1, *B1; int lda, ldb, M, N, K; const int* row_idx; const int* tile_e; long bstride; const int* dyn_rows; };
__device__ __forceinline__ int crow(int r, int hi) { return (r & 3) + 8 * (r >> 2) + 4 * hi; }

template <bool DUAL, class Epi>
__global__ __launch_bounds__(256) void k_gemm(GArgs g, Epi epi) {
    const int lane = threadIdx.x & 63, w = threadIdx.x >> 6, wm = w >> 1, wn = w & 1, r = lane & 31, hi = lane >> 5;
    const int Mrows = g.dyn_rows ? *g.dyn_rows : g.M;
    if ((int)blockIdx.y * 128 >= Mrows) return;
    const int m0 = blockIdx.y * 128 + wm * 64, n0 = blockIdx.x * 128 + wn * 64;
    long boff = 0; int e = 0;
    if (g.tile_e) { e = g.tile_e[(blockIdx.y * 128) >> 8]; boff = (long)e * g.bstride; }
    const bf16_t *pa0[2], *pa1[2], *pb0[2], *pb1[2];
#pragma unroll
    for (int i = 0; i < 2; ++i) {
        const int m = m0 + 32 * i + r; const int src = g.row_idx ? g.row_idx[m] : m;
        pa0[i] = g.A0 + (size_t)src * g.lda + hi * 32;
        pa1[i] = (g.A1 ? g.A1 : g.A0) + (size_t)src * g.lda + hi * 32;
        int n = n0 + 32 * i + r; if (n > g.N - 1) n = g.N - 1;
        pb0[i] = g.B0 + boff + (size_t)n * g.ldb + hi * 32;
        pb1[i] = (DUAL ? g.B1 : g.B0) + boff + (size_t)n * g.ldb + hi * 32;
    }
    f32x16 acc0[2][2], acc1[2][2];
#pragma unroll
    for (int i = 0; i < 2; ++i)
#pragma unroll
        for (int j = 0; j < 2; ++j) { acc0[i][j] = f32x16{}; acc1[i][j] = f32x16{}; }
    for (int k = 0; k < g.K; k += 64) {
        bf16x8 a[2][4], b[2][4];
#pragma unroll
        for (int i = 0; i < 2; ++i)
#pragma unroll
            for (int p = 0; p < 4; ++p) { a[i][p] = *(const bf16x8*)(pa0[i] + k + 8 * p); b[i][p] = *(const bf16x8*)(pb0[i] + k + 8 * p); }
#pragma unroll
        for (int p = 0; p < 4; ++p)
#pragma unroll
            for (int i = 0; i < 2; ++i)
#pragma unroll
                for (int j = 0; j < 2; ++j) acc0[i][j] = __builtin_amdgcn_mfma_f32_32x32x16_bf16(a[i][p], b[j][p], acc0[i][j], 0, 0, 0);
        if (DUAL) {
#pragma unroll
            for (int i = 0; i < 2; ++i)
#pragma unroll
                for (int p = 0; p < 4; ++p) { a[i][p] = *(const bf16x8*)(pa1[i] + k + 8 * p); b[i][p] = *(const bf16x8*)(pb1[i] + k + 8 * p); }
#pragma unroll
            for (int p = 0; p < 4; ++p)
#pragma unroll
                for (int i = 0; i < 2; ++i)
#pragma unroll
                    for (int j = 0; j < 2; ++j) acc1[i][j] = __builtin_amdgcn_mfma_f32_32x32x16_bf16(a[i][p], b[j][p], acc1[i][j], 0, 0, 0);
        }
    }
#pragma unroll
    for (int i = 0; i < 2; ++i)
#pragma unroll
        for (int j = 0; j < 2; ++j)
#pragma unroll
            for (int rg = 0; rg < 16; ++rg) {
                const int m = m0 + 32 * i + crow(rg, hi), n = n0 + 32 * j + r;
                if (n < g.N) epi(m, n, acc0[i][j][rg], acc1[i][j][rg], e);
            }
}
struct EpiProj { float *Qraw, *Kraw; bf16_t *V, *MQ, *MK, *MV, *MO, *GA, *GM;
    __device__ __forceinline__ void operator()(int m, int n, float a, float, int) const {
        if (n < 512) Qraw[(size_t)m * 512 + n] = a;
        else if (n < 1024) Kraw[(size_t)m * 512 + n - 512] = a;
        else if (n < 1536) V[(size_t)m * 512 + n - 1024] = f2bf(a);
        else if (n < 2048) MQ[(size_t)m * 512 + n - 1536] = f2bf(a);
        else if (n < 2560) MK[(size_t)m * 512 + n - 2048] = f2bf(a);
        else if (n < 3072) MV[(size_t)m * 512 + n - 2560] = f2bf(a);
        else if (n < 3584) MO[(size_t)m * 512 + n - 3072] = f2bf(sigm(a));
        else if (n < 3592) {}
        else if (n < 4616) GA[(size_t)m * 1024 + n - 3592] = f2bf(sigm(a));
        else GM[(size_t)m * 1024 + n - 4616] = f2bf(sigm(a));
    } };
struct EpiBranch { const bf16_t *GA, *GM; bf16_t* merged;
    __device__ __forceinline__ void operator()(int m, int n, float a, float b, int) const {
        const size_t o = (size_t)m * 1024 + n; merged[o] = f2bf(bf2f(GA[o]) * a + bf2f(GM[o]) * b); } };
struct EpiOut { const float* x; float* h;
    __device__ __forceinline__ void operator()(int m, int n, float a, float, int) const { const size_t o = (size_t)m * 1024 + n; h[o] = x[o] + a; } };
struct EpiMlp1 { const float* b1; bf16_t* act;
    __device__ __forceinline__ void operator()(int m, int n, float a, float b, int e) const {
        float gl = fminf(a + b1[e * 2048 + n], 7.f); float li = fminf(fmaxf(b + b1[e * 2048 + 1024 + n], -7.f), 7.f);
        act[(size_t)m * 1024 + n] = f2bf(gl * sigm(1.702f * gl) * (li + 1.f)); } };
struct EpiMlp2 { const float* b2; bf16_t* y;
    __device__ __forceinline__ void operator()(int m, int n, float a, float, int e) const { y[(size_t)m * 1024 + n] = f2bf(a + b2[e * 1024 + n]); } };

__global__ void k_rope(const float* Qraw, const float* Kraw, const float2* tab, bf16_t* Q, bf16_t* K) {
    const size_t idx = (size_t)blockIdx.x * blockDim.x + threadIdx.x;
    const int i = idx & 31, h = (idx >> 5) & 7; const size_t t = idx >> 8; const int pos = (int)(t & (SEQ - 1));
    const float2 cs = tab[pos * 32 + i]; const size_t o = t * 512 + h * 64 + i;
    { const float a = Qraw[o], b = Qraw[o + 32]; Q[o] = f2bf((a * cs.x - b * cs.y) * C2); Q[o + 32] = f2bf((b * cs.x + a * cs.y) * C2); }
    { const float a = Kraw[o], b = Kraw[o + 32]; K[o] = f2bf(a * cs.x - b * cs.y); K[o + 32] = f2bf(b * cs.x + a * cs.y); }
}
__global__ void k_kmean(const bf16_t* K, float* kmean) {
    const int h = blockIdx.x & 7, blk = (blockIdx.x >> 3) & 15, b = blockIdx.x >> 7, d = threadIdx.x;
    float s = 0.f;
    for (int r = 0; r < 256; ++r) s += bf2f(K[((size_t)(b * SEQ + blk * 256 + r)) * 512 + h * 64 + d]);
    kmean[(size_t)blockIdx.x * 64 + d] = s * (1.f / 256.f);
}
__global__ __launch_bounds__(256) void k_attn_naive(const bf16_t* Q, const bf16_t* K, const bf16_t* V, const float* kmean, bf16_t* Ya) {
    __shared__ float qs[4][64]; __shared__ float ps[4][64];
    const int w = threadIdx.x >> 6, lane = threadIdx.x & 63;
    const int h = blockIdx.x & 7; const int t = (blockIdx.x >> 3) * 4 + w; const int b = t >> 12, s = t & (SEQ - 1), j = s >> 8;
    const float qv = bf2f(Q[(size_t)t * 512 + h * 64 + lane]);
    qs[w][lane] = qv;
    float v1 = -INFINITY, v2 = -INFINITY, v3 = -INFINITY; int i1 = 0, i2 = 0, i3 = 0;
    for (int n = 0; n < j; ++n) {
        const float g = wave_sum(qv * kmean[((size_t)((b * 16 + n) * 8 + h)) * 64 + lane]);
        if (g > v1) { v3 = v2; i3 = i2; v2 = v1; i2 = i1; v1 = g; i1 = n; }
        else if (g > v2) { v3 = v2; i3 = i2; v2 = g; i2 = n; }
        else if (g > v3) { v3 = g; i3 = n; }
    }
    const int nsel = j < 3 ? j : 3;
    __syncthreads();
    float m = -1e30f, l = 0.f, o = 0.f;
    for (int kb = 0; kb <= nsel; ++kb) {
        const int nb = (kb == 0) ? j : (kb == 1 ? i1 : (kb == 2 ? i2 : i3));
        for (int tile = 0; tile < 4; ++tile) {
            const int key = nb * 256 + tile * 64 + lane;
            const bf16x8* kp = (const bf16x8*)(K + ((size_t)(b * SEQ + key)) * 512 + h * 64);
            float sc = 0.f;
#pragma unroll
            for (int c = 0; c < 8; ++c) { const bf16x8 kv = kp[c];
#pragma unroll
                for (int e = 0; e < 8; ++e) sc += qs[w][c * 8 + e] * bf2f((unsigned short)kv[e]); }
            if (kb == 0 && key > s) sc = -1e30f;
            const float mt = wave_max(sc), mn = fmaxf(m, mt);
            const float p = exp2f(sc - mn), alpha = exp2f(m - mn);
            l = l * alpha + wave_sum(p); o *= alpha; m = mn;
            ps[w][lane] = p;
            __syncthreads();
            const bf16_t* vp = V + ((size_t)(b * SEQ + nb * 256 + tile * 64)) * 512 + h * 64 + lane;
            for (int kk = 0; kk < 64; ++kk) o += ps[w][kk] * bf2f(vp[(size_t)kk * 512]);
            __syncthreads();
        }
    }
    Ya[(size_t)t * 512 + h * 64 + lane] = f2bf(o / l);
}
__global__ __launch_bounds__(256) void k_mlstm_naive(const bf16_t* MQ, const bf16_t* MK, const bf16_t* MV, const float* gates, const float* cw, const float* cb, float* Hraw) {
    const int bh = blockIdx.x, b = bh >> 2, h = bh & 3, tid = threadIdx.x, v = tid >> 1, half = tid & 1;
    __shared__ float qs[32][128], ks[32][128], vs[32][128]; __shared__ float fg[32], ig[32];
    float C[64], nn[64];
#pragma unroll
    for (int j = 0; j < 64; ++j) { C[j] = 0.f; nn[j] = 0.f; }
    for (int t0 = 0; t0 < SEQ; t0 += 32) {
        __syncthreads();
        for (int idx = tid; idx < 32 * 128; idx += 256) {
            const int s = idx >> 7, d = idx & 127, t = t0 + s;
            float aq = cb[h * 128 + d], ak = cb[512 + h * 128 + d];
#pragma unroll
            for (int j = 0; j < 4; ++j) { const int tt = t - 3 + j; if (tt >= 0) { const size_t off = ((size_t)(b * SEQ + tt)) * 512 + h * 128 + d;
                aq += cw[j * 1024 + h * 128 + d] * bf2f(MQ[off]); ak += cw[j * 1024 + 512 + h * 128 + d] * bf2f(MK[off]); } }
            qs[s][d] = aq * sigm(aq); ks[s][d] = ak * sigm(ak) * 0.08838834764831845f;
            vs[s][d] = bf2f(MV[((size_t)(b * SEQ + t)) * 512 + h * 128 + d]);
        }
        if (tid < 32) { const size_t t = (size_t)b * SEQ + t0 + tid; ig[tid] = __expf(gates[t * 8 + h]); fg[tid] = sigm(gates[t * 8 + 4 + h]); }
        __syncthreads();
        for (int s = 0; s < 32; ++s) {
            const float f = fg[s], ii = ig[s], vv = vs[s][v] * ii; float num = 0.f, den = 0.f;
#pragma unroll
            for (int j = 0; j < 64; ++j) { const float kk = ks[s][half * 64 + j], qq = qs[s][half * 64 + j];
                C[j] = f * C[j] + vv * kk; nn[j] = f * nn[j] + ii * kk; num += C[j] * qq; den += nn[j] * qq; }
            num += __shfl_xor(num, 1); den += __shfl_xor(den, 1);
            if (half == 0) Hraw[((size_t)(b * SEQ + t0 + s)) * 512 + h * 128 + v] = num / fmaxf(fabsf(den), 1.f);
        }
    }
}
__global__ __launch_bounds__(256) void k_headnorm(const float* Hraw, const float* hw, const bf16_t* MO, bf16_t* Ym) {
    const int lane = threadIdx.x & 63; const size_t idx = (size_t)blockIdx.x * 4 + (threadIdx.x >> 6); const size_t t = idx >> 2; const int h = idx & 3;
    const size_t o = t * 512 + h * 128; const float a = Hraw[o + lane], b = Hraw[o + 64 + lane];
    const float rs = rsqrtf(wave_sum(a * a + b * b) * (1.f / 128.f) + EPS);
    Ym[o + lane] = f2bf(bf2f(f2bf(a * rs * hw[h * 128 + lane])) * bf2f(MO[o + lane]));
    Ym[o + 64 + lane] = f2bf(bf2f(f2bf(b * rs * hw[h * 128 + 64 + lane])) * bf2f(MO[o + 64 + lane]));
}
__global__ __launch_bounds__(256) void k_rms2_router(const float* hbuf, const float* wn, const float* wr, const float* br, bf16_t* xn2, int* cnt, int* asg_e, int* asg_pos, float* asg_g, int* list) {
    const int row = blockIdx.x * 4 + (threadIdx.x >> 6), lane = threadIdx.x & 63;
    const float4* xr = (const float4*)(hbuf + (size_t)row * DM);
    float4 v[4]; float ss = 0.f;
#pragma unroll
    for (int j = 0; j < 4; ++j) { v[j] = xr[lane + 64 * j]; ss += v[j].x * v[j].x + v[j].y * v[j].y + v[j].z * v[j].z + v[j].w * v[j].w; }
    ss = wave_sum(ss); const float rs = rsqrtf(ss * (1.f / DM) + EPS);
    float lg[32];
#pragma unroll
    for (int e = 0; e < 32; ++e) lg[e] = 0.f;
#pragma unroll
    for (int j = 0; j < 4; ++j) {
        const float4 w = ((const float4*)wn)[lane + 64 * j];
        float y[4] = {v[j].x * rs * w.x, v[j].y * rs * w.y, v[j].z * rs * w.z, v[j].w * rs * w.w};
        const int k0 = 4 * (lane + 64 * j);
        ushort4 o; o.x = f2bf(y[0]); o.y = f2bf(y[1]); o.z = f2bf(y[2]); o.w = f2bf(y[3]);
        *(ushort4*)(xn2 + (size_t)row * DM + k0) = o;
#pragma unroll
        for (int c = 0; c < 4; ++c) { const float4* wp = (const float4*)(wr + (size_t)(k0 + c) * 32);
#pragma unroll
            for (int q = 0; q < 8; ++q) { const float4 a = wp[q]; lg[4 * q] += y[c] * a.x; lg[4 * q + 1] += y[c] * a.y; lg[4 * q + 2] += y[c] * a.z; lg[4 * q + 3] += y[c] * a.w; } }
    }
#pragma unroll
    for (int e = 0; e < 32; ++e) lg[e] = wave_sum(lg[e]) + br[e];
    float tv[4]; int ti[4];
#pragma unroll
    for (int k = 0; k < 4; ++k) {
        float bv = -INFINITY; int bi = 0;
#pragma unroll
        for (int e = 0; e < 32; ++e) if (lg[e] > bv) { bv = lg[e]; bi = e; }
#pragma unroll
        for (int e = 0; e < 32; ++e) if (e == bi) lg[e] = -INFINITY;
        tv[k] = bv; ti[k] = bi;
    }
    const float e0 = 1.f, e1 = __expf(tv[1] - tv[0]), e2 = __expf(tv[2] - tv[0]), e3 = __expf(tv[3] - tv[0]); const float inv = 1.f / (e0 + e1 + e2 + e3);
    if (lane < 4) {
        const int e = lane == 0 ? ti[0] : (lane == 1 ? ti[1] : (lane == 2 ? ti[2] : ti[3]));
        const float gq = (lane == 0 ? e0 : (lane == 1 ? e1 : (lane == 2 ? e2 : e3))) * inv;
        const int pos = atomicAdd(&cnt[e], 1);
        asg_e[row * 4 + lane] = e; asg_pos[row * 4 + lane] = pos; asg_g[row * 4 + lane] = gq; list[(size_t)e * T_TOK + pos] = row;
    }
}
__global__ __launch_bounds__(1024) void k_moe_offsets(int* ctl, const int* list, int* row_tok) {
    __shared__ int ps[33];
    if (threadIdx.x == 0) { int a = 0; for (int e = 0; e < 32; ++e) { ps[e] = a; ctl[CW_PSTART + e] = a; const int p = (ctl[CW_CNT + e] + 255) / 256 * 256; for (int q = 0; q < p / 256; ++q) ctl[CW_TILEE + a / 256 + q] = e; a += p; } ps[32] = a; ctl[CW_NROWS] = a; }
    __syncthreads();
    for (int e = 0; e < 32; ++e) { const int c = ctl[CW_CNT + e], p = ps[e + 1] - ps[e];
        for (int pos = threadIdx.x; pos < p; pos += 1024) row_tok[ps[e] + pos] = pos < c ? list[(size_t)e * T_TOK + pos] : 0; }
}
__global__ __launch_bounds__(256) void k_final(const float* hbuf, const bf16_t* yrows, const int* ctl, const int* asg_e, const int* asg_pos, const float* asg_g, const float* wf, float* out) {
    const int row = blockIdx.x * 4 + (threadIdx.x >> 6), lane = threadIdx.x & 63;
    const float4* xr = (const float4*)(hbuf + (size_t)row * DM);
    float4 v[4];
#pragma unroll
    for (int j = 0; j < 4; ++j) v[j] = xr[lane + 64 * j];
#pragma unroll
    for (int k = 0; k < 4; ++k) {
        const int e = asg_e[row * 4 + k]; const size_t r = (size_t)ctl[CW_PSTART + e] + asg_pos[row * 4 + k]; const float gq = asg_g[row * 4 + k];
#pragma unroll
        for (int j = 0; j < 4; ++j) { const ushort4 y = *(const ushort4*)(yrows + r * DM + 4 * (lane + 64 * j));
            v[j].x += gq * bf2f(y.x); v[j].y += gq * bf2f(y.y); v[j].z += gq * bf2f(y.z); v[j].w += gq * bf2f(y.w); }
    }
    float ss = 0.f;
#pragma unroll
    for (int j = 0; j < 4; ++j) ss += v[j].x * v[j].x + v[j].y * v[j].y + v[j].z * v[j].z + v[j].w * v[j].w;
    ss = wave_sum(ss); const float rs = rsqrtf(ss * (1.f / DM) + EPS);
#pragma unroll
    for (int j = 0; j < 4; ++j) { const float4 w = ((const float4*)wf)[lane + 64 * j];
        ((float4*)(out + (size_t)row * DM))[lane + 64 * j] = make_float4(v[j].x * rs * w.x, v[j].y * rs * w.y, v[j].z * rs * w.z, v[j].w * rs * w.w); }
}

extern "C" void kernel_launch(void* const* d_in, const int* in_sizes, int n_in, void* d_out, int out_size, void* d_ws, size_t ws_size, hipStream_t stream) {
    if (n_in != 17 || ws_size < WS_END * MiB) { fprintf(stderr, "kernel_launch: unexpected n_in %d / ws %zu\n", n_in, ws_size); return; }
    const float* x = (const float*)d_in[0]; const float* norm_mix_w = (const float*)d_in[1]; const float* w_in = (const float*)d_in[2];
    const float* conv_w = (const float*)d_in[3]; const float* conv_b = (const float*)d_in[4]; const float* gate_bias = (const float*)d_in[5];
    const float* head_w = (const float*)d_in[6]; const float* w_branch = (const float*)d_in[7]; const float* w_out = (const float*)d_in[8];
    const float* norm_ffn_w = (const float*)d_in[9]; const float* w_router = (const float*)d_in[10]; const float* b_router = (const float*)d_in[11];
    const float* w_mlp1 = (const float*)d_in[12]; const float* b_mlp1 = (const float*)d_in[13]; const float* w_mlp2 = (const float*)d_in[14];
    const float* b_mlp2 = (const float*)d_in[15]; const float* norm_final_w = (const float*)d_in[16];
    char* ws = (char*)d_ws; float* out = (float*)d_out;
    int* ctl = (int*)(ws + WS_CTL * MiB); float2* ropetab = (float2*)(ws + WS_ROPE * MiB); float* kmean = (float*)(ws + WS_KMEAN * MiB);
    int* asg_e = (int*)(ws + WS_ASGE * MiB); int* asg_pos = (int*)(ws + WS_ASGP * MiB); float* asg_g = (float*)(ws + WS_ASGG * MiB);
    int* row_tok = (int*)(ws + WS_ROWTOK * MiB); int* list = (int*)(ws + WS_LIST * MiB);
    bf16_t* WinT = (bf16_t*)(ws + WS_WIN * MiB); bf16_t* WbT = (bf16_t*)(ws + WS_WB * MiB); bf16_t* WoT = (bf16_t*)(ws + WS_WO * MiB);
    bf16_t* W1T = (bf16_t*)(ws + WS_W1 * MiB); bf16_t* W2T = (bf16_t*)(ws + WS_W2 * MiB);
    float* hbuf = (float*)(ws + WS_H * MiB); bf16_t* xn = (bf16_t*)(ws + WS_XN * MiB);
    bf16_t* Q = (bf16_t*)(ws + WS_Q * MiB); bf16_t* K = (bf16_t*)(ws + WS_K * MiB); bf16_t* V = (bf16_t*)(ws + WS_V * MiB);
    bf16_t* MQ = (bf16_t*)(ws + WS_MQ * MiB); bf16_t* MK = (bf16_t*)(ws + WS_MK * MiB); bf16_t* MV = (bf16_t*)(ws + WS_MV * MiB); bf16_t* MO = (bf16_t*)(ws + WS_MO * MiB);
    bf16_t* GA = (bf16_t*)(ws + WS_GA * MiB); bf16_t* GM = (bf16_t*)(ws + WS_GM * MiB);
    float* Qraw = (float*)(ws + WS_QRAW * MiB); float* Kraw = (float*)(ws + WS_KRAW * MiB); float* Hraw = (float*)(ws + WS_HRAW * MiB);
    bf16_t* merged = (bf16_t*)(ws + WS_MERGED * MiB); bf16_t* Ya = (bf16_t*)(ws + WS_YA * MiB); bf16_t* Ym = (bf16_t*)(ws + WS_YM * MiB);
    bf16_t* act = (bf16_t*)(ws + WS_ACT * MiB); bf16_t* yrows = (bf16_t*)(ws + WS_YROWS * MiB);

    hipMemsetAsync(ctl, 0, 65536, stream);
    k_transpose_bf16<<<dim3((IN_COLS + 31) / 32, 32, 1), dim3(32, 8), 0, stream>>>(w_in, WinT, 1024, IN_COLS, IN_COLS, 0, 0);
    k_transpose_bf16<<<dim3(32, 32, 1), dim3(32, 8), 0, stream>>>(w_branch, WbT, 1024, 1024, 1024, 0, 0);
    k_transpose_bf16<<<dim3(32, 32, 1), dim3(32, 8), 0, stream>>>(w_out, WoT, 1024, 1024, 1024, 0, 0);
    k_transpose_bf16<<<dim3(64, 32, 32), dim3(32, 8), 0, stream>>>(w_mlp1, W1T, 1024, 2048, 2048, (size_t)1024 * 2048, (size_t)2048 * 1024);
    k_transpose_bf16<<<dim3(32, 32, 32), dim3(32, 8), 0, stream>>>(w_mlp2, W2T, 1024, 1024, 1024, (size_t)1024 * 1024, (size_t)1024 * 1024);
    k_ropetab<<<SEQ * 32 / 256, 256, 0, stream>>>(ropetab);
    float* gates = (float*)(ws + WS_GATES * MiB);
    k_rms1<<<T_TOK / 4, 256, 0, stream>>>(x, norm_mix_w, w_in, gate_bias, xn, gates);
    {
        GArgs g{xn, WinT, nullptr, nullptr, 1024, 1024, T_TOK, IN_COLS, 1024, nullptr, nullptr, 0, nullptr};
        EpiProj ep{Qraw, Kraw, V, MQ, MK, MV, MO, GA, GM};
        k_gemm<false, EpiProj><<<dim3((IN_COLS + 127) / 128, T_TOK / 128), 256, 0, stream>>>(g, ep);
    }
    k_rope<<<T_TOK * 8 * 32 / 256, 256, 0, stream>>>(Qraw, Kraw, ropetab, Q, K);
    k_kmean<<<NB * 16 * 8, 64, 0, stream>>>(K, kmean);
    k_attn_naive<<<T_TOK / 4 * 8, 256, 0, stream>>>(Q, K, V, kmean, Ya);
    k_mlstm_naive<<<NB * 4, 256, 0, stream>>>(MQ, MK, MV, gates, conv_w, conv_b, Hraw);
    k_headnorm<<<T_TOK * 4 / 4, 256, 0, stream>>>(Hraw, head_w, MO, Ym);
    {
        GArgs g{Ya, WbT, Ym, WbT + 512, 512, 1024, T_TOK, 1024, 512, nullptr, nullptr, 0, nullptr};
        EpiBranch ep{GA, GM, merged};
        k_gemm<true, EpiBranch><<<dim3(8, T_TOK / 128), 256, 0, stream>>>(g, ep);
    }
    {
        GArgs g{merged, WoT, nullptr, nullptr, 1024, 1024, T_TOK, 1024, 1024, nullptr, nullptr, 0, nullptr};
        EpiOut ep{x, hbuf};
        k_gemm<false, EpiOut><<<dim3(8, T_TOK / 128), 256, 0, stream>>>(g, ep);
    }
    k_rms2_router<<<T_TOK / 4, 256, 0, stream>>>(hbuf, norm_ffn_w, w_router, b_router, xn, ctl + CW_CNT, asg_e, asg_pos, asg_g, list);
    k_moe_offsets<<<1, 1024, 0, stream>>>(ctl, list, row_tok);
    {
        GArgs g{xn, W1T, nullptr, W1T + (size_t)1024 * 1024, 1024, 1024, MAXROWS, 1024, 1024, row_tok, ctl + CW_TILEE, (long)2048 * 1024, ctl + CW_NROWS};
        EpiMlp1 ep{b_mlp1, act};
        k_gemm<true, EpiMlp1><<<dim3(8, MAXROWS / 128), 256, 0, stream>>>(g, ep);
    }
    {
        GArgs g{act, W2T, nullptr, nullptr, 1024, 1024, MAXROWS, 1024, 1024, nullptr, ctl + CW_TILEE, (long)1024 * 1024, ctl + CW_NROWS};
        EpiMlp2 ep{b_mlp2, yrows};
        k_gemm<false, EpiMlp2><<<dim3(8, MAXROWS / 128), 256, 0, stream>>>(g, ep);
    }
    k_final<<<T_TOK / 4, 256, 0, stream>>>(hbuf, yrows, ctl, asg_e, asg_pos, asg_g, norm_final_w, out);
}
```

```cpp
#include <hip/hip_runtime.h>
#include <stdint.h>
#include <math.h>
#include <cstdio>

typedef unsigned short bf16_t;
typedef short bf16x8 __attribute__((ext_vector_type(8)));
typedef float f32x16 __attribute__((ext_vector_type(16)));

constexpr int T_TOK = 32768, DM = 1024, SEQ = 4096, NB = 8;
constexpr int IN_COLS = 5640;
constexpr float EPS = 1e-6f;
constexpr float C2 = 0.125f * 1.4426950408889634f;
constexpr size_t MiB = 1u << 20;
constexpr size_t WS_CTL = 0, WS_ROPE = 8, WS_KMEAN = 9, WS_ASGE = 10, WS_ASGP = 11, WS_ASGG = 12, WS_ROWTOK = 13, WS_LIST = 14, WS_GATES = 18, WS_KMP = 19;
constexpr size_t WS_WIN = 20, WS_WB = 32, WS_WO = 34, WS_W1 = 36, WS_W2 = 164, WS_H = 228, WS_XN = 356;
constexpr size_t WS_Q = 420, WS_K = 452, WS_V = 484, WS_MQ = 516, WS_MK = 548, WS_MV = 580, WS_MO = 612, WS_GA = 644, WS_GM = 708;
constexpr size_t WS_QRAW = 772, WS_KRAW = 836, WS_HRAW = 772, WS_MERGED = 836, WS_YA = 900, WS_YM = 932;
constexpr size_t WS_MQC = 772, WS_MKC = 804, WS_G = 356, WS_CST = 388, WS_AB = 404, WS_NV = 405, WS_NST = 406, WS_DC = 407;
constexpr size_t WS_ACT = 420, WS_YROWS = 692, WS_END = 964;
constexpr int MAXROWS = 131072 + 32 * 256;
constexpr int CW_CNT = 0, CW_NROWS = 64, CW_PSTART = 128, CW_TILEE = 256, CW_DIAG = 1024;
constexpr size_t WS_YAREF = 964;

__device__ __forceinline__ unsigned short f2bf(float f) { unsigned u = __float_as_uint(f); u += 0x7fffu + ((u >> 16) & 1u); return (unsigned short)(u >> 16); }
__device__ __forceinline__ float bf2f(unsigned short b) { return __uint_as_float(((unsigned)b) << 16); }
__device__ __forceinline__ float wave_sum(float v) {
#pragma unroll
    for (int o = 32; o > 0; o >>= 1) v += __shfl_xor(v, o);
    return v; }
__device__ __forceinline__ float wave_max(float v) {
#pragma unroll
    for (int o = 32; o > 0; o >>= 1) v = fmaxf(v, __shfl_xor(v, o));
    return v; }
__device__ __forceinline__ float sigm(float x) { return 1.f / (1.f + __expf(-x)); }

__device__ __forceinline__ int crow(int r, int hi) { return (r & 3) + 8 * (r >> 2) + 4 * hi; }
namespace pg8 {
#define PG8_LAS __attribute__((address_space(3)))
typedef unsigned short bf16_t;
typedef short bf16x8 __attribute__((ext_vector_type(8)));
typedef float f32x4 __attribute__((ext_vector_type(4)));
typedef unsigned u32x4 __attribute__((ext_vector_type(4)));
__device__ __forceinline__ void st16_wt(void* p, u32x4 v) { asm volatile("global_store_dwordx4 %0, %1, off sc1\n\ts_nop 1" :: "v"(p), "v"(v)); }
constexpr int BM = 256, BK = 64, HALF = 128, HTB = HALF * BK * 2  , STAGE_BYTES = 8 * HTB, NXCD = 8, WGM = 8;

__host__ __device__ __forceinline__ int lds_byte(int r, int c) { const int st = (r >> 4) * 2 + (c >> 5), rr = r & 15, cc = c & 31, ob = rr * 64 + cc * 2; return st * 1024 + (ob ^ (((ob >> 9) & 1) << 5)); }
__host__ __device__ __forceinline__ void stage_rc(int b, int& R, int& C) { const int st = b / 1024, sb = b % 1024, swz = sb ^ (((sb >> 9) & 1) << 5); R = (st >> 1) * 16 + swz / 64; C = (st & 1) * 32 + (swz % 64) / 2; }
__host__ __device__ __forceinline__ int perm32(int rho) { const int n = rho >> 4, i = rho & 15; return 8 * (i >> 2) + 4 * n + (i & 3); }

struct Unit { int pm, pn, e, pnl, rtl, ui; };
struct Gemm { const bf16_t* A; const bf16_t* Bt; int M, N, K; };

struct StaticOrder {
    int nM, nN, nwg, G, c;
    __host__ __device__ void init(int M, int N, int G_, int c_) { nM = M / BM; nN = N / BM; nwg = nM * nN; G = G_; c = c_; }
    __host__ __device__ bool next(int i, Unit& u) const {
        const long L = (long)i * G + c; if (L >= nwg) return false;
        int wgid = (int)L; { const int q = nwg / NXCD, r = nwg % NXCD, xcd = wgid % NXCD, off = wgid / NXCD; wgid = (xcd < r ? xcd * (q + 1) : r * (q + 1) + (xcd - r) * q) + off; }
        const int nig = WGM * nN, gid = wgid / nig, fm = gid * WGM, gsz = (nM - fm) < WGM ? (nM - fm) : WGM;
        u.pm = fm + ((wgid % nig) % gsz); u.pn = (wgid % nig) / gsz; return true;
    }
    __device__ __forceinline__ void a_ready(const Unit&) const {}
    __device__ __forceinline__ void done(const Unit&) const {}
};

__device__ __forceinline__ unsigned cvt_pk_bf16(float lo, float hi) { typedef float f2v_ __attribute__((ext_vector_type(2))); typedef __bf16 b2v_ __attribute__((ext_vector_type(2)));
    const f2v_ v = {lo, hi}; return __builtin_bit_cast(unsigned, __builtin_convertvector(v, b2v_)); }
typedef float f32x2 __attribute__((ext_vector_type(2)));
template <class Epi, class Sched, bool ALIGN_EPI = false, bool SP2 = false, bool GATHER = false, bool FP8 = false>
__device__ __forceinline__ void gemm_phase(PG8_LAS unsigned char* lds, const Gemm g, const Sched& S, const Epi& E) {
    const int tid = threadIdx.x, wid = __builtin_amdgcn_readfirstlane(tid >> 6), lane = tid & 63, wr = wid >> 2, wc = wid & 3, fr = lane & 15, fq = lane >> 4;
    typedef int pg8_i32x4 __attribute__((ext_vector_type(4))); typedef int pg8_i32x8 __attribute__((ext_vector_type(8)));
    const int K = g.K, nt = K / BK;
    unsigned voffA[2], voffB[2];
#pragma unroll
    for (int i = 0; i < 2; ++i) { int R, C; stage_rc(tid * 16 + i * 8192, R, C); const int Rb = Epi::PERM ? ((R & ~31) + perm32(R & 31)) : R;
        voffA[i] = (unsigned)(R * K + C) * 2u; voffB[i] = (unsigned)(Rb * K + C) * 2u; }
    static_assert(!GATHER || SP2, "gather needs the SP2 loop");
    unsigned gAc[2][2] = {{0u, 0u}, {0u, 0u}}, gAn[2][2] = {{0u, 0u}, {0u, 0u}};
    const size_t kstep = (size_t)(BK * 2);
    const size_t hstep = (size_t)HALF * K * 2;
    const size_t qstep = (size_t)64 * K * 2;
    const size_t tstep = 2 * hstep;
    const unsigned ldsw = (unsigned)wid * 1024u;
    const int aoff = lds_byte(wr * 64 + fr, fq * 8), boff = lds_byte(wc * 32 + fr, fq * 8);
#define PG8_SA(b, h) (((b) * 2 + (h)) * HTB)
#define PG8_SB(b, h) ((4 + (b) * 2 + (h)) * HTB)
#define PG8_STAGE(bufoff, gbase, voff) do { _Pragma("unroll") for (int _i = 0; _i < 2; ++_i) \
        __builtin_amdgcn_global_load_lds((const unsigned*)((const char*)(gbase) + (voff)[_i]), (PG8_LAS unsigned*)(lds + (bufoff) + ldsw + _i * 8192), 16, 0, 0); } while (0)
#define PG8_STAGE1(bufoff, gbase, voff0) do { _Pragma("unroll") for (int _i = 0; _i < 2; ++_i) \
        __builtin_amdgcn_global_load_lds((const unsigned*)((const char*)(gbase) + (size_t)_i * qstep + (voff0)), (PG8_LAS unsigned*)(lds + (bufoff) + ldsw + _i * 8192), 16, 0, 0); } while (0)
#define PG8_STAGEA(bufoff, gbase, h, gsel) do { if constexpr (GATHER) { PG8_STAGE(bufoff, gbase, gsel[h]); } else { PG8_STAGE1(bufoff, (gbase) + (h) * hstep, voffA[0]); } } while (0)
#define PG8_LD16(off) (*(const PG8_LAS pg8_i32x4*)(lds + (off)))
#define PG8_LDA(dst, b, h) do { _Pragma("unroll") for (int m = 0; m < 4; ++m) { if constexpr (FP8) { dst##8[m] = __builtin_shufflevector(PG8_LD16(PG8_SA(b, h) + aoff + m * 2048), PG8_LD16(PG8_SA(b, h) + aoff + m * 2048 + 1024), 0, 1, 2, 3, 4, 5, 6, 7); } \
        else { _Pragma("unroll") for (int k = 0; k < 2; ++k) dst[m][k] = *(const PG8_LAS bf16x8*)(lds + PG8_SA(b, h) + aoff + m * 2048 + k * 1024); } } } while (0)
#define PG8_LDB(dst, b, h) do { _Pragma("unroll") for (int n = 0; n < 2; ++n) { if constexpr (FP8) { dst##8[n] = __builtin_shufflevector(PG8_LD16(PG8_SB(b, h) + boff + n * 2048), PG8_LD16(PG8_SB(b, h) + boff + n * 2048 + 1024), 0, 1, 2, 3, 4, 5, 6, 7); } \
        else { _Pragma("unroll") for (int k = 0; k < 2; ++k) dst[n][k] = *(const PG8_LAS bf16x8*)(lds + PG8_SB(b, h) + boff + n * 2048 + k * 1024); } } } while (0)
#define PG8_CAT(x0, x1) __builtin_shufflevector(__builtin_bit_cast(pg8_i32x4, x0), __builtin_bit_cast(pg8_i32x4, x1), 0, 1, 2, 3, 4, 5, 6, 7)
#define PG8_MMA(ai, bj, At, Bt) do { __builtin_amdgcn_s_setprio(1); if constexpr (FP8) { _Pragma("unroll") for (int m = 0; m < 4; ++m) _Pragma("unroll") for (int n = 0; n < 2; ++n) \
        acc[ai][bj][m][n] = __builtin_amdgcn_mfma_scale_f32_16x16x128_f8f6f4(Bt##8[n], At##8[m], acc[ai][bj][m][n], 0, 0, 0, 0x7a7a7a7a, 0, 0x7f7f7f7f); } else { \
        _Pragma("unroll") for (int m = 0; m < 4; ++m) _Pragma("unroll") for (int n = 0; n < 2; ++n) _Pragma("unroll") for (int k = 0; k < 2; ++k) \
        acc[ai][bj][m][n] = __builtin_amdgcn_mfma_f32_16x16x32_bf16(Bt[n][k], At[m][k], acc[ai][bj][m][n], 0, 0, 0); } __builtin_amdgcn_s_setprio(0); } while (0)
#define PG8_WAIT_V(n) asm volatile("s_waitcnt vmcnt(" #n ")" ::: "memory")
#define PG8_WAIT_L(n) asm volatile("s_waitcnt lgkmcnt(" #n ")" ::: "memory")
#define PG8_BAR __builtin_amdgcn_s_barrier()
#define PG8_SCHED __builtin_amdgcn_sched_barrier(0)
    Unit cur, nxt; int ui = 0;
    if (!S.next(0, cur)) return;
    f32x4 acc[2][2][4][2];
#pragma unroll
    for (int a = 0; a < 2; ++a)
#pragma unroll
        for (int b = 0; b < 2; ++b)
#pragma unroll
            for (int m = 0; m < 4; ++m)
#pragma unroll
                for (int n = 0; n < 2; ++n) acc[a][b][m][n] = (f32x4){0.f, 0.f, 0.f, 0.f};
    bf16x8 At[4][2], B0[2][2], B1[2][2]; pg8_i32x8 At8[4], B08[2], B18[2];
    const char* cA = GATHER ? (const char*)g.A : (const char*)g.A + (size_t)cur.pm * tstep; const char* cB = (const char*)g.Bt + (size_t)cur.pn * tstep;
    if constexpr (GATHER) S.gather(cur, tid, K, gAc);
    S.a_ready(cur);
    if constexpr (SP2) {
        PG8_STAGE1(PG8_SB(0, 0), cB, voffB[0]); PG8_STAGE1(PG8_SB(0, 1), cB + hstep, voffB[0]); PG8_STAGEA(PG8_SA(0, 0), cA, 0, gAc); PG8_STAGEA(PG8_SA(0, 1), cA, 1, gAc);
        if (wr == 1) PG8_BAR;
        PG8_WAIT_V(2); PG8_BAR;
        PG8_STAGE1(PG8_SB(1, 0), cB + kstep, voffB[0]); PG8_STAGEA(PG8_SA(1, 0), cA + kstep, 0, gAc); PG8_STAGE1(PG8_SB(1, 1), cB + hstep + kstep, voffB[0]);
        PG8_WAIT_V(6); PG8_BAR;
    } else {
        PG8_STAGE1(PG8_SB(0, 0), cB, voffB[0]); PG8_STAGE(PG8_SA(0, 0), cA, voffA); PG8_STAGE1(PG8_SB(0, 1), cB + hstep, voffB[0]); PG8_STAGE(PG8_SA(0, 1), cA + hstep, voffA);
        if (wr == 1) PG8_BAR;
        PG8_WAIT_V(4); PG8_BAR;
        PG8_STAGE1(PG8_SB(1, 0), cB + kstep, voffB[0]); PG8_STAGE(PG8_SA(1, 0), cA + kstep, voffA); PG8_STAGE1(PG8_SB(1, 1), cB + hstep + kstep, voffB[0]);
        PG8_WAIT_V(6); PG8_BAR;
    }
    for (;;) {
        const bool has_next = S.next(ui + 1, nxt);
        if constexpr (GATHER) { if (has_next) S.gather(nxt, tid, K, gAn); else { gAn[0][0] = gAc[0][0]; gAn[0][1] = gAc[0][1]; gAn[1][0] = gAc[1][0]; gAn[1][1] = gAc[1][1]; } }
        const char* nA = GATHER ? (const char*)g.A : (has_next ? (const char*)g.A + (size_t)nxt.pm * tstep : cA); const char* nB = has_next ? (const char*)g.Bt + (size_t)nxt.pn * tstep : cB;
#pragma unroll 1
        for (int t = 0; t < nt; t += 2) {
            if constexpr (Epi::MIDK) { if (t == nt / 2) E.midk(acc, cur, wr, wc, fr, fq); }
            const bool last = (t == nt - 2);
            const char* a1 = cA + (size_t)(t + 1) * kstep;
            const char* a2 = last ? nA : cA + (size_t)(t + 2) * kstep; const char* b2 = last ? nB : cB + (size_t)(t + 2) * kstep;
            const char* a3 = a2 + kstep; const char* b3 = b2 + kstep;
            if (last && has_next) S.a_ready(nxt);
            if constexpr (SP2) {
            PG8_LDB(B0, 0, 0); PG8_LDB(B1, 0, 1); PG8_SCHED; PG8_LDA(At, 0, 0); PG8_STAGEA(PG8_SA(1, 1), a1, 1, gAc);
            if constexpr (GATHER) { if (last) { gAc[0][0] = gAn[0][0]; gAc[0][1] = gAn[0][1]; gAc[1][0] = gAn[1][0]; gAc[1][1] = gAn[1][1]; } }
            PG8_WAIT_V(8); PG8_WAIT_L(0); PG8_BAR; PG8_MMA(0, 0, At, B0); PG8_MMA(0, 1, At, B1); PG8_BAR; PG8_SCHED;
            PG8_LDA(At, 0, 1); PG8_STAGE1(PG8_SB(0, 0), b2, voffB[0]); PG8_STAGE1(PG8_SB(0, 1), b2 + hstep, voffB[0]); PG8_STAGEA(PG8_SA(0, 0), a2, 0, gAc);
            PG8_WAIT_V(8); PG8_WAIT_L(0); PG8_BAR; PG8_MMA(1, 0, At, B0); PG8_MMA(1, 1, At, B1); PG8_BAR; PG8_SCHED;
            PG8_LDB(B0, 1, 0); PG8_LDB(B1, 1, 1); PG8_SCHED; PG8_LDA(At, 1, 0); PG8_STAGEA(PG8_SA(0, 1), a2, 1, gAc);
            PG8_WAIT_V(8); PG8_WAIT_L(0); PG8_BAR; PG8_MMA(0, 0, At, B0); PG8_MMA(0, 1, At, B1); PG8_BAR; PG8_SCHED;
            PG8_LDA(At, 1, 1); PG8_STAGE1(PG8_SB(1, 0), b3, voffB[0]); PG8_STAGE1(PG8_SB(1, 1), b3 + hstep, voffB[0]); PG8_STAGEA(PG8_SA(1, 0), a3, 0, gAc);
            PG8_WAIT_V(8); PG8_WAIT_L(0); PG8_BAR; PG8_MMA(1, 0, At, B0); PG8_MMA(1, 1, At, B1); PG8_BAR; PG8_SCHED;
            } else {
            PG8_LDB(B0, 0, 0); PG8_SCHED; PG8_LDA(At, 0, 0); PG8_STAGE(PG8_SA(1, 1), a1 + hstep, voffA);
            PG8_WAIT_L(8); PG8_BAR; PG8_WAIT_L(0); PG8_MMA(0, 0, At, B0); PG8_BAR; PG8_SCHED;
            PG8_LDB(B1, 0, 1); PG8_STAGE1(PG8_SB(0, 0), b2, voffB[0]);
            PG8_BAR; PG8_WAIT_L(0); PG8_MMA(0, 1, At, B1); PG8_BAR;
            PG8_LDA(At, 0, 1); PG8_STAGE(PG8_SA(0, 0), a2, voffA);
            PG8_BAR; PG8_WAIT_L(0); PG8_MMA(1, 0, At, B0); PG8_BAR; PG8_SCHED;
            PG8_STAGE1(PG8_SB(0, 1), b2 + hstep, voffB[0]);
            PG8_WAIT_V(6); PG8_BAR; PG8_MMA(1, 1, At, B1); PG8_BAR;
            PG8_LDB(B0, 1, 0); PG8_SCHED; PG8_LDA(At, 1, 0); PG8_STAGE(PG8_SA(0, 1), a2 + hstep, voffA);
            PG8_WAIT_L(8); PG8_BAR; PG8_WAIT_L(0); PG8_MMA(0, 0, At, B0); PG8_BAR; PG8_SCHED;
            PG8_LDB(B1, 1, 1); PG8_STAGE1(PG8_SB(1, 0), b3, voffB[0]);
            PG8_BAR; PG8_WAIT_L(0); PG8_MMA(0, 1, At, B1); PG8_BAR;
            PG8_LDA(At, 1, 1); PG8_STAGE(PG8_SA(1, 0), a3, voffA);
            PG8_BAR; PG8_WAIT_L(0); PG8_MMA(1, 0, At, B0); PG8_BAR; PG8_SCHED;
            PG8_STAGE1(PG8_SB(1, 1), b3 + hstep, voffB[0]);
            PG8_WAIT_V(6); PG8_BAR; PG8_MMA(1, 1, At, B1); PG8_BAR;
            }
        }
        if constexpr (ALIGN_EPI) { if (wr == 0) PG8_BAR; }
        if constexpr (!Epi::AFTER_DRAIN) { E(acc, cur, wr, wc, fr, fq); S.done(cur); }
        if (!has_next) break;
#pragma unroll
        for (int a = 0; a < 2; ++a)
#pragma unroll
            for (int b = 0; b < 2; ++b)
#pragma unroll
                for (int m = 0; m < 4; ++m)
#pragma unroll
                    for (int n = 0; n < 2; ++n) acc[a][b][m][n] = (f32x4){0.f, 0.f, 0.f, 0.f};
        cur = nxt; cA = nA; cB = nB; ++ui;
        if constexpr (ALIGN_EPI) { if (wr == 1) PG8_BAR; }
    }
    PG8_WAIT_V(0);
    if constexpr (!ALIGN_EPI) { if (wr == 0) PG8_BAR; }
    PG8_BAR;
    if constexpr (Epi::AFTER_DRAIN) { E.fused(acc, cur, wr, wc, fr, fq, lds, wid, lane); S.done(cur); }
#undef PG8_SA
#undef PG8_SB
#undef PG8_STAGE
#undef PG8_STAGE1
#undef PG8_STAGEA
#undef PG8_LDA
#undef PG8_LDB
#undef PG8_MMA
#undef PG8_CAT
#undef PG8_WAIT_V
#undef PG8_WAIT_L
#undef PG8_BAR
#undef PG8_SCHED
}
}
#define GAS __attribute__((address_space(1)))
#define LAS __attribute__((address_space(3)))
typedef unsigned v4u __attribute__((ext_vector_type(4)));
typedef float f32x4 __attribute__((ext_vector_type(4)));
typedef short bf16x8 __attribute__((ext_vector_type(8)));
typedef GAS unsigned gu32;
typedef GAS unsigned long long gu64;
#define RLX_AGENT __ATOMIC_RELAXED, __HIP_MEMORY_SCOPE_AGENT
#define LDS_WAIT() asm volatile("s_waitcnt lgkmcnt(0)" ::: "memory")
#define VM_WAIT() asm volatile("s_waitcnt vmcnt(0)" ::: "memory")
__device__ __forceinline__ unsigned long long rt() { return __builtin_amdgcn_s_memrealtime(); }

#define XB_TMO      128
#define XB_XCNT(j)  (256  + 64 * (j))
#define XB_XSUB(j)  (1280 + 64 * (j))
#define XB_XGEN(j)  (2304 + 64 * (j))
#define XB_TOP      3328
#define XB_TOPGEN   3392
#define XCD_BAR_WORDS 3456
#define XB_SPIN_CAP (1u << 18)

__device__ __forceinline__ unsigned xb_ld(unsigned* p)              { return __hip_atomic_load(p, __ATOMIC_RELAXED, __HIP_MEMORY_SCOPE_AGENT); }
__device__ __forceinline__ unsigned xb_add(unsigned* p, unsigned v) { return __hip_atomic_fetch_add(p, v, __ATOMIC_RELAXED, __HIP_MEMORY_SCOPE_AGENT); }
__device__ __forceinline__ unsigned xb_xcc_id() { return (unsigned)__builtin_amdgcn_s_getreg((3 << 11) | 20) & 0xFu; }
#define XB_SPIN(cond, bar) do { unsigned _sp = 0; while (cond) { __builtin_amdgcn_s_sleep(1); \
    if ((++_sp & 255u) == 0u) { if (xb_ld(&(bar)[XB_TMO])) break; if (_sp > XB_SPIN_CAP) { atomicAdd(&(bar)[XB_TMO], 1u); break; } } } } while (0)

struct XcdBarrier {
    unsigned* bar; unsigned x;
    volatile LAS unsigned* st;
};

__device__ __forceinline__ XcdBarrier xcd_barrier_post(unsigned* bar, volatile LAS unsigned* st) {
    XcdBarrier b; b.bar = bar; b.x = xb_xcc_id(); b.st = st;
    if (threadIdx.x == 0) (void)xb_add(&bar[XB_XCNT(b.x)], 1u);
    return b;
}
__device__ __forceinline__ void xcd_barrier_complete(unsigned* bar, unsigned x, unsigned& nloc, unsigned& nx) {
    const unsigned G = gridDim.x * gridDim.y * gridDim.z;
    unsigned sum, cnt, mine, sp = 0u;
    for (;;) {
        sum = 0u; cnt = 0u; mine = 0u;
#pragma unroll
        for (unsigned j = 0; j < 16; ++j) { const unsigned c = xb_ld(&bar[XB_XCNT(j)]); sum += c; cnt += (c > 0u) ? 1u : 0u; mine = (j == x) ? c : mine; }
        if (sum == G) break;
        __builtin_amdgcn_s_sleep(1);
        if ((++sp & 255u) == 0u) { if (xb_ld(&bar[XB_TMO])) break; if (sp > XB_SPIN_CAP) { atomicAdd(&bar[XB_TMO], 1u); break; } }
    }
    nloc = mine > 0u ? mine : 1u; nx = cnt > 0u ? cnt : 1u;
}

__device__ __forceinline__ void xcd_barrier(const XcdBarrier& b) {
    asm volatile("s_waitcnt vmcnt(0)" ::: "memory");
    __syncthreads();
    if (threadIdx.x == 0) {
        unsigned* bar = b.bar;
        __builtin_amdgcn_s_waitcnt(0);
        unsigned nloc = b.st[0], nx = b.st[1];
        if (nloc == 0u) { xcd_barrier_complete(bar, b.x, nloc, nx); b.st[0] = nloc; b.st[1] = nx; }
        const unsigned old = xb_add(&bar[XB_XSUB(b.x)], 1u);
        const unsigned gen = old / nloc;
        if (old + 1u == (gen + 1u) * nloc) {
            __builtin_amdgcn_fence(__ATOMIC_RELEASE, "agent");
            asm volatile("s_waitcnt vmcnt(0)" ::: "memory");
            const unsigned og = xb_add(&bar[XB_TOP], 1u);
            const unsigned tg = og / nx;
            if (og + 1u == (tg + 1u) * nx) xb_add(&bar[XB_TOPGEN], 1u);
            else XB_SPIN(xb_ld(&bar[XB_TOPGEN]) == tg, bar);
            __builtin_amdgcn_fence(__ATOMIC_ACQUIRE, "agent");
            xb_add(&bar[XB_XGEN(b.x)], 1u);
            asm volatile("s_waitcnt vmcnt(0)" ::: "memory");
        } else {
            XB_SPIN(xb_ld(&bar[XB_XGEN(b.x)]) == gen, bar);
            __builtin_amdgcn_fence(__ATOMIC_ACQUIRE, "agent");
            asm volatile("s_waitcnt vmcnt(0)" ::: "memory");
        }
    }
    __syncthreads();
}
#include <hip/hip_bf16.h>
#include <cmath>
namespace attn_body {
using bf16=__hip_bfloat16;
using bf16x8=__attribute__((ext_vector_type(8)))short;
using s16x4=__attribute__((ext_vector_type(4)))short;
using f32x16=__attribute__((ext_vector_type(16)))float;
using u32x4=__attribute__((ext_vector_type(4)))unsigned;
using f32x4v=__attribute__((ext_vector_type(4)))float;
constexpr int BATCH=8,NHEAD=8,SEQ=4096,D=64,DM=NHEAD*D;
constexpr int NW=8,QBLK=32,QB=QBLK*NW,KVBLK=64,NQB=SEQ/QB;
constexpr int ATTN_PITCH=DM, ATTN_UNIT_ROWS=QB, OPITCH=DM;
__device__ __forceinline__ int crow(int r,int hi){return (r&3)+8*(r>>2)+4*hi;}
#define SBAR() __builtin_amdgcn_sched_barrier(0)
__device__ __forceinline__ void cmask(f32x16&p0,f32x16&p1,int jb,int qrel,int hi){
  const float NEG=-INFINITY; int kb=64*jb+4*hi;
  #pragma unroll
  for(int r=0;r<16;++r){int kv=kb+(r&3)+8*(r>>2); if(kv>qrel)p0[r]=NEG; if(kv+32>qrel)p1[r]=NEG;}
}

constexpr int NSLOT=3, SLOTB=8192;
constexpr int LDS_K=0, LDS_V=NSLOT*SLOTB, LDS_WS=2*NSLOT*SLOTB, LDS_OST=LDS_WS+NW*64*4, LDS_KM=LDS_OST+NW*4096, LDS_BYTES=LDS_KM+4096;
constexpr float C2=0.125f*1.4426950408889634f;
__device__ __forceinline__ void glds16(const void*gsrc,unsigned lds_dst){unsigned keep;
  asm volatile("s_mov_b32 %0, m0\n\ts_mov_b32 m0, %2\n\ts_nop 0\n\tglobal_load_lds_dwordx4 %1, off\n\ts_mov_b32 m0, %0":"=&s"(keep):"v"(gsrc),"s"(lds_dst):"memory");}
__device__ __forceinline__ float max3f(float a,float b,float c){float r;asm("v_max3_f32 %0, %1, %2, %3":"=v"(r):"v"(a),"v"(b),"v"(c));return r;}
__device__ __forceinline__ float max2f(float a,float b){float r;asm("v_max_f32_e32 %0, %1, %2":"=v"(r):"v"(a),"v"(b));return r;}
__device__ __forceinline__ float fadd_s(float a,float b){float r;asm("v_add_f32_e32 %0, %1, %2":"=v"(r):"v"(a),"v"(b));return r;}
__device__ __forceinline__ float fsub_s(float a,float b){float r;asm("v_sub_f32_e32 %0, %1, %2":"=v"(r):"v"(a),"v"(b));return r;}
typedef float f32x2_t __attribute__((ext_vector_type(2))); typedef __bf16 bf16x2_t __attribute__((ext_vector_type(2)));
__device__ __forceinline__ unsigned cvtpk_s(float lo,float hi){f32x2_t v={lo,hi};bf16x2_t b=__builtin_convertvector(v,bf16x2_t);return __builtin_bit_cast(unsigned,b);}
#define WAIT_BAR(N) asm volatile("s_waitcnt vmcnt(" #N ") lgkmcnt(0)\n\ts_barrier":::"memory")

__device__ __forceinline__ void qkt(f32x16&p0,f32x16&p1,const char*Kslot,const bf16x8*qr,const f32x16&negm,int r32,int hi){
  const char*kb=Kslot+hi*1024+r32*16;
  #pragma unroll
  for(int d0=0;d0<4;++d0){
    const bf16x8 b0=*reinterpret_cast<const bf16x8*>(kb+d0*2048);
    const bf16x8 b1=*reinterpret_cast<const bf16x8*>(kb+d0*2048+512);
    if(d0==0){p0=__builtin_amdgcn_mfma_f32_32x32x16_bf16(b0,qr[0],negm,0,0,0);p1=__builtin_amdgcn_mfma_f32_32x32x16_bf16(b1,qr[0],negm,0,0,0);}
    else{p0=__builtin_amdgcn_mfma_f32_32x32x16_bf16(b0,qr[d0],p0,0,0,0);p1=__builtin_amdgcn_mfma_f32_32x32x16_bf16(b1,qr[d0],p1,0,0,0);}}
}
typedef __attribute__((address_space(3))) const char* lds_cptr;
typedef short v4i16_t __attribute__((ext_vector_type(4)));
__device__ __forceinline__ void kload8(bf16x8*kf,lds_cptr kp){
  kf[0]=*(const __attribute__((address_space(3))) bf16x8*)(kp);      kf[1]=*(const __attribute__((address_space(3))) bf16x8*)(kp+512);
  kf[2]=*(const __attribute__((address_space(3))) bf16x8*)(kp+2048); kf[3]=*(const __attribute__((address_space(3))) bf16x8*)(kp+2560);
  kf[4]=*(const __attribute__((address_space(3))) bf16x8*)(kp+4096); kf[5]=*(const __attribute__((address_space(3))) bf16x8*)(kp+4608);
  kf[6]=*(const __attribute__((address_space(3))) bf16x8*)(kp+6144); kf[7]=*(const __attribute__((address_space(3))) bf16x8*)(kp+6656);
}
__device__ __forceinline__ void kload2(bf16x8*kf,lds_cptr kp,int j){ kf[2*j]=*(const __attribute__((address_space(3))) bf16x8*)(kp+j*2048); kf[2*j+1]=*(const __attribute__((address_space(3))) bf16x8*)(kp+j*2048+512); }
__device__ __forceinline__ s16x4 vtr(lds_cptr p){ return __builtin_bit_cast(s16x4,__builtin_amdgcn_ds_read_tr16_b64_v4i16((__attribute__((address_space(3))) v4i16_t*)p)); }
__device__ __forceinline__ float rowmax(const f32x16&p0,const f32x16&p1){
  float a=max3f(p0[0],p0[1],p1[0]),b=max3f(p0[2],p0[3],p1[1]);a=max3f(a,p1[2],p1[3]);
  #pragma unroll
  for(int r=4;r<16;r+=4){a=max3f(a,p0[r],p0[r+1]);b=max3f(b,p0[r+2],p0[r+3]);a=max3f(a,p1[r],p1[r+1]);b=max3f(b,p1[r+2],p1[r+3]);}
  const float m=max2f(a,b);
  auto rr=__builtin_amdgcn_permlane32_swap(__float_as_uint(m),__float_as_uint(m),false,false);
  return max2f(__uint_as_float(rr[0]),__uint_as_float(rr[1]));
}
__device__ __forceinline__ void pv(f32x16*o,int vb,bf16x8 pa0,bf16x8 pa1,bf16x8 pa2,bf16x8 pa3){
  #pragma unroll
  for(int d0=0;d0<2;++d0){s16x4 lo[4],hi[4];
    #pragma unroll
    for(int ks=0;ks<4;++ks){
      asm volatile("ds_read_b64_tr_b16 %0,%1 offset:%c2":"=&v"(lo[ks]):"v"(vb),"i"(d0*4096+ks*1024):"memory");
      asm volatile("ds_read_b64_tr_b16 %0,%1 offset:%c2":"=&v"(hi[ks]):"v"(vb),"i"(d0*4096+ks*1024+512):"memory");}
    asm volatile("s_waitcnt lgkmcnt(0)":::"memory");SBAR();
    #define PK(k) (bf16x8){lo[k][0],lo[k][1],lo[k][2],lo[k][3],hi[k][0],hi[k][1],hi[k][2],hi[k][3]}
    o[d0]=__builtin_amdgcn_mfma_f32_32x32x16_bf16(pa0,PK(0),o[d0],0,0,0);
    o[d0]=__builtin_amdgcn_mfma_f32_32x32x16_bf16(pa1,PK(1),o[d0],0,0,0);
    o[d0]=__builtin_amdgcn_mfma_f32_32x32x16_bf16(pa2,PK(2),o[d0],0,0,0);
    o[d0]=__builtin_amdgcn_mfma_f32_32x32x16_bf16(pa3,PK(3),o[d0],0,0,0);
    #undef PK
  }
}

#ifndef ATTN_STORE16
#define ATTN_STORE16(p,v) (*(u32x4*)(p)=(v))
#endif
template<int THRL> __device__ __forceinline__ void attn_unit(int b,int h,int qb,const bf16*Q,const bf16*__restrict__ K,const bf16*__restrict__ V,bf16*O,char*shm){
  const int tid=threadIdx.x,lane=tid&63,r32=lane&31,hi=lane>>5; const int wid=__builtin_amdgcn_readfirstlane(tid>>6);
  const long rowbase=(long)b*SEQ; const int q0=qb*QB;
  const bf16*Qw=Q+(rowbase+q0+wid*QBLK)*DM+h*D;
  const bf16*Kh=K+rowbase*DM+h*D,*Vh=V+rowbase*DM+h*D;
  const unsigned lds0=(unsigned)(uintptr_t)shm;
  float*wsf=(float*)(shm+LDS_WS)+wid*64;
  const bf16*ksrc=Kh+(long)lane*DM+wid*8;
  const bf16*vsrc=Vh+(long)(16*(wid&3)+(lane>>2))*DM+(wid>>2)*32+(lane&3)*8;
  const unsigned kdst=lds0+LDS_K+wid*1024, vdst=lds0+LDS_V+wid*1024;
  #define DMA_K(t,slot) glds16(ksrc+(long)(t)*KVBLK*DM,(unsigned)__builtin_amdgcn_readfirstlane(kdst+(slot)))
  #define DMA_V(t,slot) glds16(vsrc+(long)(t)*KVBLK*DM,(unsigned)__builtin_amdgcn_readfirstlane(vdst+(slot)))
  const int vb0=(int)(lds0+LDS_V)+((lane>>4)&1)*32+(lane&3)*8+(4*hi+((lane&15)>>2))*64;
  const char*Kbase=shm+LDS_K; bf16x8 kf[8];
  const lds_cptr shm3=(lds_cptr)shm; const lds_cptr kp0=shm3+LDS_K+hi*1024+r32*16; const lds_cptr vp0=shm3+LDS_V+((lane>>4)&1)*32+(lane&3)*8+(4*hi+((lane&15)>>2))*64;
  const int NT=(q0+QB)/KVBLK;
  DMA_K(0,0);DMA_V(0,0);DMA_K(1,SLOTB);
  bf16x8 qr[4];
  #pragma unroll
  for(int d0=0;d0<4;++d0)qr[d0]=*reinterpret_cast<const bf16x8*>(&Qw[(long)r32*DM+d0*16+hi*8]);
  unsigned selm=0u;
  if(qb>0){
    float q32[32];
    #pragma unroll
    for(int d0=0;d0<4;++d0){
      #pragma unroll
      for(int j=0;j<8;++j)q32[d0*8+j]=__uint_as_float(((unsigned)(unsigned short)qr[d0][j])<<16);}
    float v1=-INFINITY,v2=-INFINITY,v3=-INFINITY;int i1=0,i2=0,i3=0;
    const float*km=(const float*)(shm+LDS_KM);
    for(int n=0;n<qb;++n){
      float g=0.f;
      #pragma unroll
      for(int d0=0;d0<4;++d0){
        const f32x4v ka=*(const f32x4v*)(km+n*64+d0*16+hi*8),kb=*(const f32x4v*)(km+n*64+d0*16+hi*8+4);
        #pragma unroll
        for(int j=0;j<4;++j){g+=q32[d0*8+j]*ka[j];g+=q32[d0*8+4+j]*kb[j];}}
      {auto rr=__builtin_amdgcn_permlane32_swap(__float_as_uint(g),__float_as_uint(g),false,false);g=__uint_as_float(rr[0])+__uint_as_float(rr[1]);}
      if(g>v1){v3=v2;i3=i2;v2=v1;i2=i1;v1=g;i1=n;}else if(g>v2){v3=v2;i3=i2;v2=g;i2=n;}else if(g>v3){v3=g;i3=n;}
    }
    selm=(1u<<i1)|(qb>=2?(1u<<i2):0u)|(qb>=3?(1u<<i3):0u);
  }
  float mhat=0.f,l_reg=0.f;f32x16 o[2];o[0]=f32x16{};o[1]=f32x16{};f32x16 negm=f32x16{};asm volatile("":"+v"(negm));
  #define SETNEG(t) do{ const int t_=(t); const bool s_=(t_>=NT-4)||(((selm>>(t_>>2))&1u)!=0u); const float v_=s_?-mhat:-1e30f; \
    _Pragma("unroll") for(int r=0;r<16;++r)negm[r]=v_; asm volatile("":"+v"(negm)); }while(0)
  const int qrel=wid*QBLK+r32;
  #define CMASK(P0,P1,t) do{int jb_=(t)-(NT-4); if(jb_>=0)cmask(P0,P1,jb_,qrel,hi);}while(0)
  bool resc=false;
  #define START(P0,P1) do{ const float rm=rowmax(P0,P1); resc=false; \
    { const float dl=(rm<-1e29f)?0.f:rm; mhat=fadd_s(mhat,dl); \
      _Pragma("unroll") for(int r=0;r<16;++r){P0[r]=fsub_s(P0[r],dl);P1[r]=fsub_s(P1[r],dl);} \
      _Pragma("unroll") for(int r=0;r<16;++r)negm[r]=-mhat; asm volatile("":"+v"(negm)); } \
    _Pragma("unroll") for(int r=0;r<16;++r)P0[r]=__builtin_amdgcn_exp2f(P0[r]); }while(0)
  #define RESC() do{ if(resc){ asm volatile("s_waitcnt lgkmcnt(0)":::"memory"); \
      _Pragma("unroll") for(int d_=0;d_<2;++d_) _Pragma("unroll") for(int r=0;r<16;++r)o[d_][r]*=wsf[crow(r,hi)]; } }while(0)
  f32x16 pA0,pA1,pB0,pB1;
  int sl_prev=0,sl_cur=0,sl_next=SLOTB;
  #define ROT() do{sl_prev=sl_cur;sl_cur=sl_next;sl_next=(sl_next==(NSLOT-1)*SLOTB)?0:sl_next+SLOTB;}while(0)
  DMA_K(2,2*SLOTB);
  WAIT_BAR(3);
  SETNEG(0); qkt(pA0,pA1,Kbase,qr,negm,r32,hi);asm volatile("s_nop 15\n\ts_nop 7":"+v"(pA0),"+v"(pA1));CMASK(pA0,pA1,0);
  START(pA0,pA1);
  _Pragma("unroll") for(int r=0;r<16;++r)pA1[r]=__builtin_amdgcn_exp2f(pA1[r]);
  WAIT_BAR(0);
  DMA_K(3,0);DMA_V(1,SLOTB);
  ROT();
  kload8(kf,kp0+sl_cur);
  WAIT_BAR(2);
  s16x4 vlo[8],vhi[8]; u32x4 pw0,pw1,pw2,pw3;
  #define PKW(P,B) cvtpk_s(P[B],P[B+1])
  #define PAF(k) __builtin_bit_cast(bf16x8,pw##k)
  #define VFR(i) (bf16x8){vlo[i][0],vlo[i][1],vlo[i][2],vlo[i][3],vhi[i][0],vhi[i][1],vhi[i][2],vhi[i][3]}
  #define PIN(x) asm volatile("":"+v"(x))
  #define MX3(a,b,c) __builtin_fmaxf(__builtin_fmaxf((a),(b)),(c))
  #define GAPA(MF,A0,A1,A2,A3,W0,W1,PW) do{ MF; sacc+=A0; sacc+=A1; sacc+=A2; sacc+=A3; PIN(sacc); W0; W1; PIN(PW); SBAR(); }while(0)
  #define EX(v) __builtin_amdgcn_exp2f(v)
  #define GAPB(MF,X,B) do{ MF; X[B]=EX(X[B]); X[B+1]=EX(X[B+1]); X[B+2]=EX(X[B+2]); X[B+3]=EX(X[B+3]); PIN(X); SBAR(); }while(0)
  #define VRD(i) do{ vlo[i]=vtr(vp_+(((i)>>2)*4096+((i)&3)*1024)); vhi[i]=vtr(vp_+(((i)>>2)*4096+((i)&3)*1024+512)); }while(0)
  #define KRD(G,j) do{ if(G){ kload2(kf,kp0+sl_next,j); SBAR(); } }while(0)
  #define STEP(C0,C1,P0,P1,t,GK,GV,GL) do{ SETNEG(t); SBAR(); \
    const lds_cptr vp_=vp0+sl_prev; \
    VRD(0); SBAR(); float sacc=(P0[0]+P0[1]); \
    GAPA(C0=__builtin_amdgcn_mfma_f32_32x32x16_bf16(kf[0],qr[0],negm,0,0,0), P0[2],P0[3],P0[4],P0[5],     pw0[0]=PKW(P0,0), pw0[1]=PKW(P0,2), pw0); \
    VRD(4); SBAR(); GAPA(C1=__builtin_amdgcn_mfma_f32_32x32x16_bf16(kf[1],qr[0],negm,0,0,0), P0[6],P0[7],P0[8],P0[9],     pw0[2]=PKW(P0,4), pw0[3]=PKW(P0,6), pw0); \
    VRD(1); SBAR(); GAPA(C0=__builtin_amdgcn_mfma_f32_32x32x16_bf16(kf[2],qr[1],C0,0,0,0),   P0[10],P0[11],P0[12],P0[13], pw1[0]=PKW(P0,8), pw1[1]=PKW(P0,10), pw1); \
    VRD(5); SBAR(); GAPA(C1=__builtin_amdgcn_mfma_f32_32x32x16_bf16(kf[3],qr[1],C1,0,0,0),   P0[14],P0[15],P1[0],P1[1],   pw1[2]=PKW(P0,12),pw1[3]=PKW(P0,14), pw1); \
    VRD(2); SBAR(); GAPA(C0=__builtin_amdgcn_mfma_f32_32x32x16_bf16(kf[4],qr[2],C0,0,0,0),   P1[2],P1[3],P1[4],P1[5],     pw2[0]=PKW(P1,0), pw2[1]=PKW(P1,2), pw2); \
    VRD(6); SBAR(); GAPA(C1=__builtin_amdgcn_mfma_f32_32x32x16_bf16(kf[5],qr[2],C1,0,0,0),   P1[6],P1[7],P1[8],P1[9],     pw2[2]=PKW(P1,4), pw2[3]=PKW(P1,6), pw2); \
    VRD(3); SBAR(); GAPA(C0=__builtin_amdgcn_mfma_f32_32x32x16_bf16(kf[6],qr[3],C0,0,0,0),   P1[10],P1[11],P1[12],P1[13], pw3[0]=PKW(P1,8), pw3[1]=PKW(P1,10), pw3); \
    VRD(7); SBAR(); GAPA(C1=__builtin_amdgcn_mfma_f32_32x32x16_bf16(kf[7],qr[3],C1,0,0,0),   P1[14],P1[15],0.f,0.f,       pw3[2]=PKW(P1,12),pw3[3]=PKW(P1,14), pw3); \
    l_reg+=sacc; \
    if(GK){DMA_K((t)+3,sl_cur);} if(GV){DMA_V((t)+1,sl_next);} \
    CMASK(C0,C1,t); \
    { float a=MX3(C0[0],C0[1],C1[0]),b=MX3(C0[2],C0[3],C1[1]); a=MX3(a,C1[2],C1[3]); \
      _Pragma("unroll") for(int r=4;r<16;r+=4){a=MX3(a,C0[r],C0[r+1]);b=MX3(b,C0[r+2],C0[r+3]);a=MX3(a,C1[r],C1[r+1]);b=MX3(b,C1[r+2],C1[r+3]);} \
      float rm=__builtin_fmaxf(a,b); { auto rr=__builtin_amdgcn_permlane32_swap(__float_as_uint(rm),__float_as_uint(rm),false,false); rm=__builtin_fmaxf(__uint_as_float(rr[0]),__uint_as_float(rr[1])); } \
      resc=false; \
      if(__builtin_expect(__any(rm>(float)THRL),0)){ const float dl=__builtin_fmaxf(rm,0.f); mhat+=dl; \
        _Pragma("unroll") for(int r=0;r<16;++r){C0[r]-=dl;C1[r]-=dl;} \
        _Pragma("unroll") for(int r=0;r<16;++r)negm[r]=-mhat; asm volatile("":"+v"(negm)); \
        const float f=__builtin_amdgcn_exp2f(-dl); l_reg*=f; if(hi==0)wsf[r32]=f; resc=true; } } \
    SBAR(); \
    GAPB(o[0]=__builtin_amdgcn_mfma_f32_32x32x16_bf16(PAF(0),VFR(0),o[0],0,0,0), C0,0); \
    GAPB(o[1]=__builtin_amdgcn_mfma_f32_32x32x16_bf16(PAF(0),VFR(4),o[1],0,0,0), C0,4); \
    KRD(GL,0); GAPB(o[0]=__builtin_amdgcn_mfma_f32_32x32x16_bf16(PAF(1),VFR(1),o[0],0,0,0), C0,8); \
    KRD(GL,1); GAPB(o[1]=__builtin_amdgcn_mfma_f32_32x32x16_bf16(PAF(1),VFR(5),o[1],0,0,0), C0,12); \
    KRD(GL,2); GAPB(o[0]=__builtin_amdgcn_mfma_f32_32x32x16_bf16(PAF(2),VFR(2),o[0],0,0,0), C1,0); \
    KRD(GL,3); GAPB(o[1]=__builtin_amdgcn_mfma_f32_32x32x16_bf16(PAF(2),VFR(6),o[1],0,0,0), C1,4); \
    GAPB(o[0]=__builtin_amdgcn_mfma_f32_32x32x16_bf16(PAF(3),VFR(3),o[0],0,0,0), C1,8); \
    GAPB(o[1]=__builtin_amdgcn_mfma_f32_32x32x16_bf16(PAF(3),VFR(7),o[1],0,0,0), C1,12); \
    }while(0)
  int t=1;
  #undef CMASK
  #define CMASK(P0,P1,t) do{}while(0)
  for(;t+5<NT;t+=2){
    STEP(pB0,pB1,pA0,pA1,t,true,true,true);     WAIT_BAR(2); RESC(); ROT();
    STEP(pA0,pA1,pB0,pB1,t+1,true,true,true);   WAIT_BAR(2); RESC(); ROT();
  }
  #undef CMASK
  #define CMASK(P0,P1,t) do{int jb_=(t)-(NT-4); if(jb_>=0)cmask(P0,P1,jb_,qrel,hi);}while(0)
  #define ENDW(tt) do{ if((tt)+3<NT){WAIT_BAR(2);} else if((tt)+2<NT){WAIT_BAR(1);} else {WAIT_BAR(0);} }while(0)
  for(;t+1<NT;t+=2){
    STEP(pB0,pB1,pA0,pA1,t,(t+3<NT),(t+1<NT),(t+1<NT));       ENDW(t);   RESC(); ROT();
    STEP(pA0,pA1,pB0,pB1,t+1,(t+4<NT),(t+2<NT),(t+2<NT));     ENDW(t+1); RESC(); ROT();
  }
  STEP(pB0,pB1,pA0,pA1,NT-1,false,false,false); RESC();
  { float sacc=pB0[0]+pB0[1]; _Pragma("unroll") for(int r=2;r<16;++r)sacc+=pB0[r]; _Pragma("unroll") for(int r=0;r<16;++r)sacc+=pB1[r]; l_reg+=sacc;
    pw0=(u32x4){PKW(pB0,0),PKW(pB0,2),PKW(pB0,4),PKW(pB0,6)};pw1=(u32x4){PKW(pB0,8),PKW(pB0,10),PKW(pB0,12),PKW(pB0,14)};pw2=(u32x4){PKW(pB1,0),PKW(pB1,2),PKW(pB1,4),PKW(pB1,6)};pw3=(u32x4){PKW(pB1,8),PKW(pB1,10),PKW(pB1,12),PKW(pB1,14)};
    SBAR(); pv(o,vb0+sl_cur,PAF(0),PAF(1),PAF(2),PAF(3)); }
  #undef PKW
  #undef PAF
  #undef VFR
  #undef PIN
  #undef MX3
  #undef GAPA
  #undef GAPB
  #undef EX
  #undef VRD
  #undef KRD
  #undef STEP
  #undef ENDW
  {auto rr=__builtin_amdgcn_permlane32_swap(__float_as_uint(l_reg),__float_as_uint(l_reg),false,false);l_reg=__uint_as_float(rr[0])+__uint_as_float(rr[1]);}
  if(hi==0)wsf[32+r32]=l_reg;asm volatile("s_waitcnt lgkmcnt(0)":::"memory");
  float rli[16];
  #pragma unroll
  for(int r=0;r<16;++r)rli[r]=__builtin_amdgcn_rcpf(wsf[32+crow(r,hi)]);
  bf16*Ow=O+(rowbase+q0+wid*QBLK)*OPITCH+h*D;
  { bf16*stg=(bf16*)(shm+LDS_OST)+wid*2048;
    #pragma unroll
    for(int r=0;r<16;++r){const int orow=crow(r,hi);
      #pragma unroll
      for(int d0=0;d0<2;++d0)stg[orow*64+d0*32+r32]=__float2bfloat16(o[d0][r]*rli[r]);}
    asm volatile("s_waitcnt lgkmcnt(0)":::"memory");
    #pragma unroll
    for(int i=0;i<4;++i){const int row=i*8+(lane>>3),ch=lane&7; const u32x4 v=*(const u32x4*)(stg+row*64+ch*8); ATTN_STORE16(Ow+(long)row*OPITCH+ch*8,v);} }
  asm volatile("s_waitcnt lgkmcnt(0)\n\ts_barrier":::"memory");
  #undef SETNEG
  #undef DMA_K
  #undef DMA_V
  #undef CMASK
  #undef START
  #undef RESC
  #undef ROT
}
constexpr int ATTN_LDS_BYTES=LDS_BYTES;
struct AttnTensors { const bf16* Q; const bf16* K; const bf16* V; bf16* O; const float* kmp; };
struct AttnUnit { int bh; int qb; };
struct StaticOrder {
  int vcu, G, dbl;
  __device__ __forceinline__ explicit StaticOrder(int grid,int block,int dbl_=0):vcu((grid%8==0)?(block%8)*(grid/8)+block/8:block),G(grid),dbl(dbl_){}
  __device__ __forceinline__ bool next(int i,AttnUnit&u)const{
    i>>=dbl;
    if(G==256){ if(i>=4)return false; const int s=vcu&3; u.bh=vcu>>2; u.qb=(i==0)?15-s:(i==1)?8+s:(i==2)?7-s:s; return true; }
    const int L=i*G+vcu; if(L>=BATCH*NHEAD*NQB)return false; u.bh=L>>4; u.qb=15-(L&15); return true; }
  __device__ __forceinline__ void a_ready(const AttnUnit&)const{}
  __device__ __forceinline__ void done(const AttnUnit&)const{}
};
template<class Sched,int THRL=8> __device__ __forceinline__ void attn_phase(char*lds,const AttnTensors&T,const Sched&S){
  AttnUnit u; int bh_cur=-1;
  for(int i=0;S.next(i,u);++i){ S.a_ready(u);
    if(u.bh!=bh_cur){ bh_cur=u.bh; const int tid=threadIdx.x;
      if(tid<256){ const int n=tid>>4,seg=tid&15; const float*p0=T.kmp+((size_t)((u.bh/NHEAD)*16+n))*512+(u.bh%NHEAD)*64+seg*4;
        const f32x4v a=*(const f32x4v*)p0,b2=*(const f32x4v*)(p0+(size_t)BATCH*16*512); *(f32x4v*)(lds+LDS_KM+(n*64+seg*4)*4)=(a+b2)*(1.0f/256.0f); }
      asm volatile("s_waitcnt vmcnt(0) lgkmcnt(0)\n\ts_barrier":::"memory"); }
    attn_unit<THRL>(u.bh/NHEAD,u.bh%NHEAD,u.qb,T.Q,T.K,T.V,T.O,lds); S.done(u); }
}
#undef SBAR
#undef WAIT_BAR
}
constexpr int NWAVES = 8;
constexpr int LDS_BYTES = 160 * 1024;
constexpr int MISC_OFF = LDS_BYTES - 1024;
constexpr int CW_BAR = 4096;
constexpr int TIN = 5632;

namespace pg8 {
struct EpiProj {
    static constexpr bool PERM = true, AFTER_DRAIN = false, MIDK = false;
    unsigned char* pbase; const float2* rope; float* kmp;
    __device__ __forceinline__ void operator()(const f32x4 (&acc)[2][2][4][2], const Unit& u, int wr, int wc, int fr, int fq) const {
        const int pn = u.pn; const int row0 = u.pm * BM + wr * 64 + fr;
        if (pn < 4) {
            bf16_t* dst = (bf16_t*)(pbase + (size_t)(pn >> 1) * (32u << 20)); const float sc = pn < 2 ? C2 : 1.f; const int hcol = ((pn & 1) * 4 + wc) * 64 + 8 * fq;
            float ksl[8], ksh[8];
#pragma unroll
            for (int e = 0; e < 8; ++e) { ksl[e] = 0.f; ksh[e] = 0.f; }
#pragma unroll
            for (int ai = 0; ai < 2; ++ai)
#pragma unroll
                for (int m = 0; m < 4; ++m) {
                    const int row = row0 + ai * HALF + m * 16; const int pos = row & (SEQ - 1);
                    const float4* tp = (const float4*)(rope + pos * 32 + 8 * fq);
                    float lo[8], hi[8];
#pragma unroll
                    for (int q = 0; q < 4; ++q) { const float4 t = tp[q];
                        const int n = q >> 1, e0 = (q & 1) * 2;
                        { const float a = acc[ai][0][m][n][e0], b = acc[ai][1][m][n][e0]; lo[2 * q] = (a * t.x - b * t.y) * sc; hi[2 * q] = (b * t.x + a * t.y) * sc; }
                        { const float a = acc[ai][0][m][n][e0 + 1], b = acc[ai][1][m][n][e0 + 1]; lo[2 * q + 1] = (a * t.z - b * t.w) * sc; hi[2 * q + 1] = (b * t.z + a * t.w) * sc; } }
                    u32x4 w0, w1;
                    w0.x = cvt_pk_bf16(lo[0], lo[1]); w0.y = cvt_pk_bf16(lo[2], lo[3]); w0.z = cvt_pk_bf16(lo[4], lo[5]); w0.w = cvt_pk_bf16(lo[6], lo[7]);
                    w1.x = cvt_pk_bf16(hi[0], hi[1]); w1.y = cvt_pk_bf16(hi[2], hi[3]); w1.z = cvt_pk_bf16(hi[4], hi[5]); w1.w = cvt_pk_bf16(hi[6], hi[7]);
                    bf16_t* rp = dst + (size_t)row * 512 + hcol;
                    *(u32x4*)rp = w0; *(u32x4*)(rp + 32) = w1;
#pragma unroll
                    for (int e = 0; e < 8; ++e) { ksl[e] += lo[e]; ksh[e] += hi[e]; }
                }
            if (pn >= 2) {
#pragma unroll
                for (int e = 0; e < 8; ++e) {
#pragma unroll
                    for (int o = 1; o < 16; o <<= 1) { ksl[e] += __shfl_xor(ksl[e], o); ksh[e] += __shfl_xor(ksh[e], o); } }
                if (fr == 0) {
                    float* kp = kmp + ((size_t)((wr * NB + (u.pm >> 4)) * 16 + (u.pm & 15))) * 512 + hcol;
                    *(float4*)kp = make_float4(ksl[0], ksl[1], ksl[2], ksl[3]); *(float4*)(kp + 4) = make_float4(ksl[4], ksl[5], ksl[6], ksl[7]);
                    *(float4*)(kp + 32) = make_float4(ksh[0], ksh[1], ksh[2], ksh[3]); *(float4*)(kp + 36) = make_float4(ksh[4], ksh[5], ksh[6], ksh[7]);
                }
            }
        } else {
            if (pn >= 14) {
                unsigned char* dst8 = pbase + (size_t)(7 + 2 * ((pn - 14) >> 2)) * (32u << 20);
                const int col0 = ((pn - 14) & 3) * 256 + wc * 64 + 16 * fq;
#pragma unroll
                for (int ai = 0; ai < 2; ++ai)
#pragma unroll
                    for (int m = 0; m < 4; ++m) { unsigned char* rowp = dst8 + (size_t)(row0 + ai * HALF + m * 16) * 1024 + col0;
                        unsigned pk[4];
#pragma unroll
                        for (int bj = 0; bj < 2; ++bj) { const f32x4 v0 = acc[ai][bj][m][0], v1 = acc[ai][bj][m][1];
                            unsigned q[8];
#pragma unroll
                            for (int e = 0; e < 4; ++e) { q[e] = (unsigned)(255.f * __builtin_amdgcn_rcpf(1.f + __expf(-v0[e])) + 0.5f); q[4 + e] = (unsigned)(255.f * __builtin_amdgcn_rcpf(1.f + __expf(-v1[e])) + 0.5f); }
                            pk[2 * bj] = q[0] | (q[1] << 8) | (q[2] << 16) | (q[3] << 24); pk[2 * bj + 1] = q[4] | (q[5] << 8) | (q[6] << 16) | (q[7] << 24); }
                        *(u32x4*)rowp = (u32x4){pk[0], pk[1], pk[2], pk[3]}; }
            } else {
            bf16_t* dst; int ldc, colt; const bool sg = pn >= 12;
            dst = (bf16_t*)(pbase + (size_t)(2 + ((pn - 4) >> 1)) * (32u << 20)); ldc = 512; colt = ((pn - 4) & 1) * 256;
            const int col0 = colt + wc * 32 + 8 * fq;
#pragma unroll
            for (int ai = 0; ai < 2; ++ai)
#pragma unroll
                for (int m = 0; m < 4; ++m) { bf16_t* rowp = dst + (size_t)(row0 + ai * HALF + m * 16) * ldc + col0;
#pragma unroll
                    for (int bj = 0; bj < 2; ++bj) { f32x4 v0 = acc[ai][bj][m][0], v1 = acc[ai][bj][m][1];
                        if (sg) {
#pragma unroll
                            for (int e = 0; e < 4; ++e) { v0[e] = __builtin_amdgcn_rcpf(1.f + __expf(-v0[e])); v1[e] = __builtin_amdgcn_rcpf(1.f + __expf(-v1[e])); } }
                        u32x4 w; w.x = cvt_pk_bf16(v0[0], v0[1]); w.y = cvt_pk_bf16(v0[2], v0[3]); w.z = cvt_pk_bf16(v1[0], v1[1]); w.w = cvt_pk_bf16(v1[2], v1[3]);
                        *(u32x4*)(rowp + bj * HALF) = w; } }
            }
        }
    }
};
}

typedef float f32x4v __attribute__((ext_vector_type(4)));
struct MArgs { const float* in[17]; float* out; unsigned char* ws; int ph_lo, ph_hi, bar_region, flags; };

struct Frame {
    LAS unsigned char* lds; int tid, lane, wave, vcu, G;
};
__device__ __forceinline__ unsigned pk2(float lo, float hi) { return (unsigned)f2bf(lo) | ((unsigned)f2bf(hi) << 16); }


constexpr int WR_PITCH = 1032;
__device__ __forceinline__ unsigned cvtpk_(float lo, float hi) { typedef float f2v_ __attribute__((ext_vector_type(2))); typedef __bf16 b2v_ __attribute__((ext_vector_type(2)));
    const f2v_ v = {lo, hi}; return __builtin_bit_cast(unsigned, __builtin_convertvector(v, b2v_)); }
template <int NH>
__device__ __forceinline__ void rowproj_batch(const float* src, int row0, int lane, const LAS bf16_t* whi, const LAS bf16_t* wlo, f32x4v (&acc)[NH], float& rs) {
    const int r = lane & 15, kq = lane >> 4;
    const float* xr = src + (size_t)(row0 + r) * DM + 8 * kq;
#pragma unroll
    for (int h = 0; h < NH; ++h) acc[h] = (f32x4v){0.f, 0.f, 0.f, 0.f};
    float ssp = 0.f;
#pragma unroll 4
    for (int s = 0; s < 32; ++s) {
        const f32x4v a0 = *(const f32x4v*)(xr + 32 * s), a1 = *(const f32x4v*)(xr + 32 * s + 4);
        ssp += (a0[0] * a0[0] + a0[1] * a0[1]) + (a0[2] * a0[2] + a0[3] * a0[3]) + (a1[0] * a1[0] + a1[1] * a1[1]) + (a1[2] * a1[2] + a1[3] * a1[3]);
        v4u hv, lv;
        hv.x = cvtpk_(a0[0], a0[1]); hv.y = cvtpk_(a0[2], a0[3]); hv.z = cvtpk_(a1[0], a1[1]); hv.w = cvtpk_(a1[2], a1[3]);
        lv.x = cvtpk_(a0[0] - __uint_as_float(hv.x << 16), a0[1] - __uint_as_float(hv.x & 0xffff0000u)); lv.y = cvtpk_(a0[2] - __uint_as_float(hv.y << 16), a0[3] - __uint_as_float(hv.y & 0xffff0000u));
        lv.z = cvtpk_(a1[0] - __uint_as_float(hv.z << 16), a1[1] - __uint_as_float(hv.z & 0xffff0000u)); lv.w = cvtpk_(a1[2] - __uint_as_float(hv.w << 16), a1[3] - __uint_as_float(hv.w & 0xffff0000u));
        const bf16x8 ah = __builtin_bit_cast(bf16x8, hv), al = __builtin_bit_cast(bf16x8, lv);
#pragma unroll
        for (int h = 0; h < NH; ++h) {
            const bf16x8 bh = *(const LAS bf16x8*)(whi + (16 * h + r) * WR_PITCH + 32 * s + 8 * kq), bl = *(const LAS bf16x8*)(wlo + (16 * h + r) * WR_PITCH + 32 * s + 8 * kq);
            acc[h] = __builtin_amdgcn_mfma_f32_16x16x32_bf16(ah, bh, acc[h], 0, 0, 0);
            acc[h] = __builtin_amdgcn_mfma_f32_16x16x32_bf16(ah, bl, acc[h], 0, 0, 0);
            acc[h] = __builtin_amdgcn_mfma_f32_16x16x32_bf16(al, bh, acc[h], 0, 0, 0);
        }
    }
    ssp += __shfl_xor(ssp, 16); ssp += __shfl_xor(ssp, 32);
    rs = rsqrtf(ssp * (1.f / DM) + EPS);
}
__device__ __forceinline__ void write_norm_rows(const float* src, bf16_t* dst, int row0, int lane, float rs, const float* wn) {
    const int r = lane & 15, kq = lane >> 4;
    const float* xr = src + (size_t)(row0 + r) * DM + 8 * kq; const float* wp = wn + 8 * kq; bf16_t* dp = dst + (size_t)(row0 + r) * DM + 8 * kq;
#pragma unroll 4
    for (int s = 0; s < 32; ++s) {
        const f32x4v a0 = *(const f32x4v*)(xr + 32 * s), a1 = *(const f32x4v*)(xr + 32 * s + 4), w0 = *(const f32x4v*)(wp + 32 * s), w1 = *(const f32x4v*)(wp + 32 * s + 4);
        const f32x4v y0 = a0 * rs * w0, y1 = a1 * rs * w1;
        v4u o; o.x = cvtpk_(y0[0], y0[1]); o.y = cvtpk_(y0[2], y0[3]); o.z = cvtpk_(y1[0], y1[1]); o.w = cvtpk_(y1[2], y1[3]);
        *(v4u*)(dp + 32 * s) = o;
    }
}
__device__ __forceinline__ void write_norm_rows_f8(const float* src, unsigned char* dst, int row0, int lane, float rs, const float* wn) {
    const int r = lane & 15, kq = lane >> 4;
    const float* xr = src + (size_t)(row0 + r) * DM + 8 * kq; const float* wp = wn + 8 * kq; unsigned char* dp = dst + (size_t)(row0 + r) * DM + 8 * kq;
#pragma unroll 4
    for (int s = 0; s < 32; ++s) {
        const f32x4v a0 = *(const f32x4v*)(xr + 32 * s), a1 = *(const f32x4v*)(xr + 32 * s + 4), w0 = *(const f32x4v*)(wp + 32 * s), w1 = *(const f32x4v*)(wp + 32 * s + 4);
        const f32x4v y0 = a0 * rs * w0, y1 = a1 * rs * w1;
        int p0 = __builtin_amdgcn_cvt_pk_fp8_f32(y0[0], y0[1], 0, false); p0 = __builtin_amdgcn_cvt_pk_fp8_f32(y0[2], y0[3], p0, true);
        int p1 = __builtin_amdgcn_cvt_pk_fp8_f32(y1[0], y1[1], 0, false); p1 = __builtin_amdgcn_cvt_pk_fp8_f32(y1[2], y1[3], p1, true);
        *(uint2*)(dp + 32 * s) = make_uint2((unsigned)p0, (unsigned)p1);
    }
}

constexpr bool H_BF16 = true;
template <int NH>
__device__ __forceinline__ void rowproj_batch_bf(const bf16_t* src, int row0, int lane, const LAS bf16_t* whi, const LAS bf16_t* wlo, f32x4v (&acc)[NH], float& rs) {
    const int r = lane & 15, kq = lane >> 4;
    const bf16_t* xr = src + (size_t)(row0 + r) * DM + 8 * kq;
#pragma unroll
    for (int h = 0; h < NH; ++h) acc[h] = (f32x4v){0.f, 0.f, 0.f, 0.f};
    float ssp = 0.f;
#pragma unroll 4
    for (int s = 0; s < 32; ++s) {
        const v4u hv = *(const v4u*)(xr + 32 * s);
#pragma unroll
        for (int q = 0; q < 4; ++q) { const float a = __uint_as_float(hv[q] << 16), b = __uint_as_float(hv[q] & 0xffff0000u); ssp += a * a + b * b; }
        const bf16x8 ah = __builtin_bit_cast(bf16x8, hv);
#pragma unroll
        for (int h = 0; h < NH; ++h) {
            const bf16x8 bh = *(const LAS bf16x8*)(whi + (16 * h + r) * WR_PITCH + 32 * s + 8 * kq), bl = *(const LAS bf16x8*)(wlo + (16 * h + r) * WR_PITCH + 32 * s + 8 * kq);
            acc[h] = __builtin_amdgcn_mfma_f32_16x16x32_bf16(ah, bh, acc[h], 0, 0, 0);
            acc[h] = __builtin_amdgcn_mfma_f32_16x16x32_bf16(ah, bl, acc[h], 0, 0, 0);
        }
    }
    ssp += __shfl_xor(ssp, 16); ssp += __shfl_xor(ssp, 32);
    rs = rsqrtf(ssp * (1.f / DM) + EPS);
}
__device__ __forceinline__ void write_norm_rows_f8_bf(const bf16_t* src, unsigned char* dst, int row0, int lane, float rs, const float* wn) {
    const int r = lane & 15, kq = lane >> 4;
    const bf16_t* xr = src + (size_t)(row0 + r) * DM + 8 * kq; const float* wp = wn + 8 * kq; unsigned char* dp = dst + (size_t)(row0 + r) * DM + 8 * kq;
#pragma unroll 4
    for (int s = 0; s < 32; ++s) {
        const v4u hv = *(const v4u*)(xr + 32 * s); const f32x4v w0 = *(const f32x4v*)(wp + 32 * s), w1 = *(const f32x4v*)(wp + 32 * s + 4);
        const float y0 = __uint_as_float(hv.x << 16) * rs * w0[0], y1 = __uint_as_float(hv.x & 0xffff0000u) * rs * w0[1], y2 = __uint_as_float(hv.y << 16) * rs * w0[2], y3 = __uint_as_float(hv.y & 0xffff0000u) * rs * w0[3];
        const float y4 = __uint_as_float(hv.z << 16) * rs * w1[0], y5 = __uint_as_float(hv.z & 0xffff0000u) * rs * w1[1], y6 = __uint_as_float(hv.w << 16) * rs * w1[2], y7 = __uint_as_float(hv.w & 0xffff0000u) * rs * w1[3];
        int p0 = __builtin_amdgcn_cvt_pk_fp8_f32(y0, y1, 0, false); p0 = __builtin_amdgcn_cvt_pk_fp8_f32(y2, y3, p0, true);
        int p1 = __builtin_amdgcn_cvt_pk_fp8_f32(y4, y5, 0, false); p1 = __builtin_amdgcn_cvt_pk_fp8_f32(y6, y7, p1, true);
        *(uint2*)(dp + 32 * s) = make_uint2((unsigned)p0, (unsigned)p1);
    }
}
__device__ __forceinline__ void stage_wsplit(const float* W, int ldw, int col0, int ncols, int npad, const float* wn, LAS bf16_t* whi, LAS bf16_t* wlo, int tid) {
    const int total = 1024 * npad;
    for (int base = tid; base < total; base += 16 * NWAVES * 64) {
        float v[16], s[16];
#pragma unroll
        for (int u = 0; u < 16; ++u) { const int idx = base + u * NWAVES * 64; const int k = idx / npad, n = idx % npad; const bool ok = idx < total && n < ncols;
            v[u] = ok ? W[(size_t)k * ldw + col0 + n] : 0.f; s[u] = ok ? wn[k] : 0.f; }
#pragma unroll
        for (int u = 0; u < 16; ++u) { const int idx = base + u * NWAVES * 64; if (idx < total) { const int k = idx / npad, n = idx % npad;
            const float p = v[u] * s[u]; const unsigned short hi = f2bf(p); whi[n * WR_PITCH + k] = hi; wlo[n * WR_PITCH + k] = f2bf(p - bf2f(hi)); } }
    }
}
__device__ __forceinline__ void stage_wsplit_dense32(const float* W, const float* wn, LAS bf16_t* whi, LAS bf16_t* wlo, int tid) {
    const int n = tid & 31, k0 = tid >> 5;
    const float* wp = W + tid; const float* sp = wn + k0; LAS bf16_t* hp = whi + n * WR_PITCH + k0; LAS bf16_t* lp = wlo + n * WR_PITCH + k0;
#pragma unroll 1
    for (int b = 0; b < 8; ++b) {
        float v[8], s[8];
#pragma unroll
        for (int u = 0; u < 8; ++u) { v[u] = wp[u * 512]; s[u] = sp[u * 16]; }
#pragma unroll
        for (int u = 0; u < 8; ++u) { const float p = v[u] * s[u]; const unsigned short hi = f2bf(p); hp[u * 16] = hi; lp[u * 16] = f2bf(p - bf2f(hi)); }
        wp += 4096; sp += 128; hp += 128; lp += 128;
    }
}
__device__ __forceinline__ void stage_wsplit_gates8(const float* w_in, const float* wn, LAS bf16_t* whi, LAS bf16_t* wlo, int tid) {
    const int k0 = tid >> 1, n0 = 4 * (tid & 1);
    f32x4v v[4]; float s[4];
#pragma unroll
    for (int u = 0; u < 4; ++u) { const int k = k0 + 256 * u; v[u] = *(const f32x4v*)(w_in + (size_t)k * IN_COLS + 3584 + n0); s[u] = wn[k]; }
    {
        const v4u z = {0u, 0u, 0u, 0u};
#pragma unroll
        for (int c = 0; c < 2; ++c) { const int ch = tid + 512 * c, row = 8 + (ch >> 7), off = (ch & 127) * 8;
            *(LAS v4u*)(whi + row * WR_PITCH + off) = z; *(LAS v4u*)(wlo + row * WR_PITCH + off) = z; }
    }
#pragma unroll
    for (int u = 0; u < 4; ++u) { const int k = k0 + 256 * u;
#pragma unroll
        for (int e = 0; e < 4; ++e) { const float p = v[u][e] * s[u]; const unsigned short hi = f2bf(p); whi[(n0 + e) * WR_PITCH + k] = hi; wlo[(n0 + e) * WR_PITCH + k] = f2bf(p - bf2f(hi)); } }
}
struct P0Item { const float* src; unsigned char* dst; int ldw, pitch, f8; };
constexpr bool MOE2_FP8 = true;
constexpr bool MOE1_FP8 = true;
constexpr bool W1_PERM = true;
constexpr int I_IN = 16 * 176, I_B = 16 * 32, I_O = 16 * 32, I_1 = 32 * 16 * 64, I_2 = 32 * 16 * 32, NITEMS = I_IN + I_B + I_O + I_1 + I_2;
constexpr int NSMALL = I_IN + I_B + I_O, J_1 = 32 * 8 * 64, J_2 = 32 * 8 * 32;
__device__ __forceinline__ P0Item p0_item(int it, const MArgs& a, int lane) {
    unsigned char* ws = a.ws;
    const float* W; bf16_t* WT; int ldw, srccol0, Kd, dstrow0, k0, f8 = 0;
    int r = it;
    if (r < I_IN) { const int kb = r / 176, ng = r % 176, pn = ng >> 3, g8 = ng & 7;
        if (pn < 4) srccol0 = (pn < 2 ? 0 : 512) + 256 * (pn & 1) + 64 * (g8 & 3) + 32 * (g8 >> 2);
        else if (pn < 14) srccol0 = 1024 + 256 * (pn - 4) + 32 * g8;
        else srccol0 = 3592 + 256 * (pn - 14) + 32 * g8;
        W = a.in[2]; ldw = IN_COLS; WT = (bf16_t*)(ws + WS_WIN * MiB); Kd = 1024; dstrow0 = 32 * ng; k0 = 64 * kb; }
    else if ((r -= I_IN) < I_B) { const int kb = r >> 5, hm = kb >> 3;
        W = a.in[7] + (size_t)hm * 512 * 1024; ldw = 1024; srccol0 = 32 * (r & 31); WT = (bf16_t*)(ws + WS_WB * MiB) + (size_t)hm * 1024 * 512; Kd = 512; dstrow0 = 32 * (r & 31); k0 = 64 * (kb & 7); }
    else if ((r -= I_B) < I_O) { W = a.in[8]; ldw = 1024; srccol0 = 32 * (r & 31); WT = (bf16_t*)(ws + WS_WO * MiB); Kd = 1024; dstrow0 = 32 * (r & 31); k0 = 64 * (r >> 5); }
    else if ((r -= I_O) < I_1) { const int e = r >> 10, kb = (r >> 6) & 15, ng = r & 63;
        srccol0 = W1_PERM ? (((ng & 7) >> 2) * 1024 + 128 * (ng >> 3) + 32 * (ng & 3)) : 32 * ng;
        W = a.in[12] + (size_t)e * 1024 * 2048; ldw = 2048; WT = (bf16_t*)(ws + WS_W1 * MiB) + (size_t)e * 2048 * 1024; Kd = 1024; dstrow0 = 32 * ng; k0 = 64 * kb; f8 = MOE1_FP8 ? 1 : 0; }
    else { r -= I_1; const int e = r >> 9, kb = (r >> 5) & 15, ng = r & 31;
        W = a.in[14] + (size_t)e * 1024 * 1024; ldw = 1024; srccol0 = 32 * ng; WT = (bf16_t*)(ws + WS_W2 * MiB) + (size_t)e * 1024 * 1024; Kd = 1024; dstrow0 = 32 * ng; k0 = 64 * kb; f8 = MOE2_FP8 ? 2 : 0; }
    const int kc = lane >> 3, n4 = lane & 7;
    P0Item d; d.src = W + (size_t)(k0 + 8 * kc) * ldw + srccol0 + 4 * n4; d.ldw = ldw; d.f8 = f8;
    if (f8) { unsigned char* mat = ws + (f8 == 1 ? WS_W1 : WS_W2) * MiB; unsigned char* base8 = mat + ((size_t)((unsigned char*)WT - mat) >> 1);
        d.dst = base8 + (size_t)(dstrow0 + 4 * n4) * Kd + k0 + 8 * kc; d.pitch = Kd; }
    else { d.dst = (unsigned char*)(WT + (size_t)(dstrow0 + 4 * n4) * Kd + k0 + 8 * kc); d.pitch = Kd * 2; }
    return d;
}
__device__ __forceinline__ void p0_load(const P0Item& d, f32x4v (&r)[8]) {
#pragma unroll
    for (int j = 0; j < 8; ++j) r[j] = *(const f32x4v*)(d.src + (size_t)j * d.ldw);
}
__device__ __forceinline__ void p0_store(const P0Item& d, const f32x4v (&r)[8]) {
    if (d.f8) {
#pragma unroll
        for (int i = 0; i < 4; ++i) { int w0 = __builtin_amdgcn_cvt_pk_fp8_f32(r[0][i] * 32.f, r[1][i] * 32.f, 0, false); w0 = __builtin_amdgcn_cvt_pk_fp8_f32(r[2][i] * 32.f, r[3][i] * 32.f, w0, true);
            int w1 = __builtin_amdgcn_cvt_pk_fp8_f32(r[4][i] * 32.f, r[5][i] * 32.f, 0, false); w1 = __builtin_amdgcn_cvt_pk_fp8_f32(r[6][i] * 32.f, r[7][i] * 32.f, w1, true);
            *(uint2*)(d.dst + (size_t)i * d.pitch) = make_uint2((unsigned)w0, (unsigned)w1); }
    } else {
#pragma unroll
        for (int i = 0; i < 4; ++i) { v4u o; o.x = pk2(r[0][i], r[1][i]); o.y = pk2(r[2][i], r[3][i]); o.z = pk2(r[4][i], r[5][i]); o.w = pk2(r[6][i], r[7][i]);
            *(v4u*)(d.dst + (size_t)i * d.pitch) = o; }
    }
}

struct P8Item { const float* src; unsigned char* dst; int ldw; };
__device__ __forceinline__ P8Item p0_fp8_item(int it, const MArgs& a, int lane) {
    unsigned char* ws = a.ws;
    const float* W; unsigned char* WT; int ldw, srccol0, dstrow0, k0; bool w2perm = false;
    if (it < J_1) { const int e = it >> 9, kb = (it >> 6) & 7, ng = it & 63;
        srccol0 = ((ng & 7) >> 2) * 1024 + 128 * (ng >> 3) + 32 * (ng & 3);
        W = a.in[12] + (size_t)e * 1024 * 2048; ldw = 2048; WT = ws + WS_W1 * MiB + (size_t)e * 2048 * 1024; dstrow0 = 32 * ng; k0 = 128 * kb; }
    else { const int r = it - J_1, e = r >> 8, kb = (r >> 5) & 7, ng = r & 31;
        W = a.in[14] + (size_t)e * 1024 * 1024; ldw = 1024; srccol0 = 32 * ng; WT = ws + WS_W2 * MiB + (size_t)e * 1024 * 1024; dstrow0 = 32 * ng; k0 = 128 * kb; w2perm = true; }
    const int kc = lane >> 3, n4 = lane & 7;
    int drow = dstrow0 + 4 * n4;
    if (w2perm) { const int lt = drow & 255; drow = (drow & ~255) + 128 * ((lt >> 3) & 1) + 32 * (lt >> 6) + 8 * ((lt >> 4) & 3) + (lt & 7); }
    P8Item d; d.src = W + (size_t)(k0 + 16 * kc) * ldw + srccol0 + 4 * n4; d.dst = WT + (size_t)drow * 1024 + k0 + 16 * kc; d.ldw = ldw;
    return d;
}
__device__ __forceinline__ void p0_fp8_store(const P8Item& d, const f32x4v (&r)[16]) {
#pragma unroll
    for (int i = 0; i < 4; ++i) { v4u o;
#pragma unroll
        for (int q = 0; q < 4; ++q) { int w = __builtin_amdgcn_cvt_pk_fp8_f32(r[4 * q][i] * 32.f, r[4 * q + 1][i] * 32.f, 0, false); w = __builtin_amdgcn_cvt_pk_fp8_f32(r[4 * q + 2][i] * 32.f, r[4 * q + 3][i] * 32.f, w, true); o[q] = (unsigned)w; }
        *(v4u*)(d.dst + (size_t)i * 1024) = o; }
}
__device__ __forceinline__ void p0_fp8_weights(const Frame& F, const MArgs& a) {
    const int gw = F.vcu * NWAVES + F.wave, NGW = F.G * NWAVES;
    for (int it = gw; it < J_1 + J_2; it += 2 * NGW) {
        const bool two = it + NGW < J_1 + J_2;
        const P8Item d0 = p0_fp8_item(it, a, F.lane), d1 = p0_fp8_item(two ? it + NGW : it, a, F.lane);
        f32x4v r0[16], r1[16];
#pragma unroll
        for (int j = 0; j < 16; ++j) r0[j] = *(const f32x4v*)(d0.src + (size_t)j * d0.ldw);
#pragma unroll
        for (int j = 0; j < 16; ++j) r1[j] = *(const f32x4v*)(d1.src + (size_t)j * d1.ldw);
        p0_fp8_store(d0, r0); if (two) p0_fp8_store(d1, r1);
    }
}

struct HookOrder : pg8::StaticOrder {
    const Frame* F; const MArgs* a; int trigger; mutable int count;
    __device__ __forceinline__ void done(const pg8::Unit&) const { if (++count == trigger) p0_fp8_weights(*F, *a); }
};

struct XRows { f32x4v v[32]; };
__device__ __forceinline__ void xrows_load(XRows& R, const float* x, int bt, int lane) {
    const int r = lane & 15, kq = lane >> 4;
    const float* xr = x + (size_t)(bt * 8 + (r & 7)) * DM + 512 * (r >> 3) + 8 * kq;
#pragma unroll
    for (int s = 0; s < 16; ++s) { R.v[2 * s] = *(const f32x4v*)(xr + 32 * s); R.v[2 * s + 1] = *(const f32x4v*)(xr + 32 * s + 4); }
}
__device__ __forceinline__ void p0_batch8(const XRows& R, int bt, int lane, const LAS bf16_t* whi, const LAS bf16_t* wlo, const float* wn, const float* gbias, bf16_t* xn, float* gates) {
    const int r = lane & 15, kq = lane >> 4, half = r >> 3;
    float ssp = 0.f;
#pragma unroll
    for (int s = 0; s < 16; ++s) {
        const f32x4v a0 = R.v[2 * s], a1 = R.v[2 * s + 1];
        ssp += (a0[0] * a0[0] + a0[1] * a0[1]) + (a0[2] * a0[2] + a0[3] * a0[3]) + (a1[0] * a1[0] + a1[1] * a1[1]) + (a1[2] * a1[2] + a1[3] * a1[3]);
    }
    ssp += __shfl_xor(ssp, 16); ssp += __shfl_xor(ssp, 32); ssp += __shfl_xor(ssp, 8);
    const float rs = rsqrtf(ssp * (1.f / DM) + EPS);
    const float* wp = wn + 512 * half + 8 * kq; bf16_t* dp = xn + (size_t)(bt * 8 + (r & 7)) * DM + 512 * half + 8 * kq;
#pragma unroll
    for (int s = 0; s < 16; ++s) {
        const f32x4v a0 = R.v[2 * s], a1 = R.v[2 * s + 1], w0 = *(const f32x4v*)(wp + 32 * s), w1 = *(const f32x4v*)(wp + 32 * s + 4);
        const f32x4v y0 = a0 * rs * w0, y1 = a1 * rs * w1;
        v4u o; o.x = cvtpk_(y0[0], y0[1]); o.y = cvtpk_(y0[2], y0[3]); o.z = cvtpk_(y1[0], y1[1]); o.w = cvtpk_(y1[2], y1[3]);
        *(v4u*)(dp + 32 * s) = o;
        if ((s & 3) == 3) __builtin_amdgcn_sched_barrier(0);
    }
    f32x4v acc0 = (f32x4v){0.f, 0.f, 0.f, 0.f}, acc1 = (f32x4v){0.f, 0.f, 0.f, 0.f};
    const LAS bf16_t* bhp = whi + r * WR_PITCH + 8 * kq; const LAS bf16_t* blp = wlo + r * WR_PITCH + 8 * kq;
#pragma unroll
    for (int s = 0; s < 16; ++s) {
        const f32x4v a0 = R.v[2 * s], a1 = R.v[2 * s + 1];
        v4u hv, lv;
        hv.x = cvtpk_(a0[0], a0[1]); hv.y = cvtpk_(a0[2], a0[3]); hv.z = cvtpk_(a1[0], a1[1]); hv.w = cvtpk_(a1[2], a1[3]);
        lv.x = cvtpk_(a0[0] - __uint_as_float(hv.x << 16), a0[1] - __uint_as_float(hv.x & 0xffff0000u)); lv.y = cvtpk_(a0[2] - __uint_as_float(hv.y << 16), a0[3] - __uint_as_float(hv.y & 0xffff0000u));
        lv.z = cvtpk_(a1[0] - __uint_as_float(hv.z << 16), a1[1] - __uint_as_float(hv.z & 0xffff0000u)); lv.w = cvtpk_(a1[2] - __uint_as_float(hv.w << 16), a1[3] - __uint_as_float(hv.w & 0xffff0000u));
        const bf16x8 ah = __builtin_bit_cast(bf16x8, hv), al = __builtin_bit_cast(bf16x8, lv);
        const bf16x8 bh0 = *(const LAS bf16x8*)(bhp + 32 * s), bl0 = *(const LAS bf16x8*)(blp + 32 * s), bh1 = *(const LAS bf16x8*)(bhp + 512 + 32 * s), bl1 = *(const LAS bf16x8*)(blp + 512 + 32 * s);
        acc0 = __builtin_amdgcn_mfma_f32_16x16x32_bf16(ah, bh0, acc0, 0, 0, 0); acc0 = __builtin_amdgcn_mfma_f32_16x16x32_bf16(ah, bl0, acc0, 0, 0, 0); acc0 = __builtin_amdgcn_mfma_f32_16x16x32_bf16(al, bh0, acc0, 0, 0, 0);
        acc1 = __builtin_amdgcn_mfma_f32_16x16x32_bf16(ah, bh1, acc1, 0, 0, 0); acc1 = __builtin_amdgcn_mfma_f32_16x16x32_bf16(ah, bl1, acc1, 0, 0, 0); acc1 = __builtin_amdgcn_mfma_f32_16x16x32_bf16(al, bh1, acc1, 0, 0, 0);
        if (s & 1) __builtin_amdgcn_sched_barrier(0);
    }
    {
        const int n = lane & 15, g = lane >> 4;
#pragma unroll
        for (int i = 0; i < 4; ++i) { const float t = __shfl(acc1[i], (lane + 32) & 63); const float rsm = __shfl(rs, (4 * g + i) & 7);
            if (g < 2 && n < 8) gates[(size_t)(bt * 8 + 4 * g + i) * 8 + n] = (acc0[i] + t) * rsm + gbias[n]; }
    }
}
__device__ __forceinline__ void p0_prologue(const Frame& F, const MArgs& a) {
    unsigned char* ws = a.ws;
    const int gw = F.vcu * NWAVES + F.wave, NGW = F.G * NWAVES;
    constexpr int NBF = (MOE1_FP8 && MOE2_FP8) ? NSMALL : NITEMS;
    for (int it = gw; it < NBF; it += 2 * NGW) {
        const bool two = it + NGW < NBF;
        const P0Item d0 = p0_item(it, a, F.lane), d1 = p0_item(two ? it + NGW : it, a, F.lane);
        f32x4v r0[8], r1[8];
        p0_load(d0, r0); p0_load(d1, r1);
        p0_store(d0, r0); if (two) p0_store(d1, r1);
    }
    float2* tab = (float2*)(ws + WS_ROPE * MiB);
    for (int idx = gw * 64 + F.lane; idx < SEQ * 32; idx += NGW * 64) {
        const int pos = idx >> 5, i = idx & 31;
        const float inv = exp2f(-(float)(2 * i) * (13.287712379549449f / 64.0f));
        const float ang = (float)pos * inv;
        tab[idx] = make_float2(cosf(ang), sinf(ang));
    }
    const float* x = a.in[0]; const float* wn = a.in[1]; const float* w_in = a.in[2]; const float* gbias = a.in[5];
    LAS bf16_t* whi = (LAS bf16_t*)F.lds; LAS bf16_t* wlo = whi + 16 * WR_PITCH;
    bf16_t* xn = (bf16_t*)(ws + WS_XN * MiB); float* gates = (float*)(ws + WS_GATES * MiB);
    __syncthreads();
    for (int bt = gw; bt < T_TOK / 8; bt += NGW) { XRows R; xrows_load(R, x, bt, F.lane);
        if (bt == gw) { stage_wsplit_gates8(w_in, wn, whi, wlo, F.tid); __syncthreads(); }
        p0_batch8(R, bt, F.lane, whi, wlo, wn, gbias, xn, gates); }
}
constexpr int CNT_STRIDE = 64;
constexpr int TP_OFF = 32;
namespace pg8 {
struct GroupedOrder {
    int nN, nwg, G, c, R; const volatile PG8_LAS int* tp; const int* list; const int* cnt;
    __device__ __forceinline__ void init(int R_, int nN_, int G_, int c_, const volatile PG8_LAS int* tp_, const int* list_, const int* cnt_) { R = __builtin_amdgcn_readfirstlane(R_); nN = nN_; nwg = R * nN_; G = G_; c = c_; tp = tp_; list = list_; cnt = cnt_; }
    __device__ __forceinline__ bool next(int i, Unit& u) const {
        const long L = (long)i * G + c; if (L >= nwg) return false;
        int wgid = (int)L; { const int q = nwg / NXCD, r = nwg % NXCD, xcd = wgid % NXCD, off = wgid / NXCD; wgid = (xcd < r ? xcd * (q + 1) : r * (q + 1) + (xcd - r) * q) + off; }
        const int nig = WGM * nN, gid = wgid / nig, fm = gid * WGM, gsz = (R - fm) < WGM ? (R - fm) : WGM;
        const int pm = fm + ((wgid % nig) % gsz), pn = (wgid % nig) / gsz;
        int e = 0;
#pragma unroll
        for (int s = 16; s > 0; s >>= 1) { if (tp[e + s] <= pm) e += s; }
        e = __builtin_amdgcn_readfirstlane(e);
        u.pm = pm; u.e = e; u.rtl = pm - __builtin_amdgcn_readfirstlane(tp[e]); u.pnl = pn; u.pn = e * nN + pn; return true;
    }
    __device__ __forceinline__ bool next_lane(int i, int& pm_, int& pn_, int& e_, int& rtl_) const {
        const long L = (long)i * G + c; if (L >= nwg) return false;
        int wgid = (int)L; { const int q = nwg / NXCD, r = nwg % NXCD, xcd = wgid % NXCD, off = wgid / NXCD; wgid = (xcd < r ? xcd * (q + 1) : r * (q + 1) + (xcd - r) * q) + off; }
        const int nig = WGM * nN, gid = wgid / nig, fm = gid * WGM, gsz = (R - fm) < WGM ? (R - fm) : WGM;
        const int pm = fm + ((wgid % nig) % gsz), pn = (wgid % nig) / gsz;
        int e = 0;
#pragma unroll
        for (int s = 16; s > 0; s >>= 1) { if (tp[e + s] <= pm) e += s; }
        pm_ = pm; pn_ = pn; e_ = e; rtl_ = pm - tp[e]; return true;
    }
    __device__ __forceinline__ void gather(const Unit& u, int tid, int K, unsigned (&out)[2][2]) const {
        if (list == nullptr) {
#pragma unroll
            for (int i = 0; i < 2; ++i) { int R_, C_; stage_rc(tid * 16 + i * 8192, R_, C_);
#pragma unroll
                for (int h = 0; h < 2; ++h) out[h][i] = (unsigned)((u.pm * 256 + h * 128 + R_) * K + C_) * 2u; }
            return; }
        const int ce = cnt[u.e * CNT_STRIDE];
#pragma unroll
        for (int i = 0; i < 2; ++i) { int R_, C_; stage_rc(tid * 16 + i * 8192, R_, C_);
#pragma unroll
            for (int h = 0; h < 2; ++h) { const int pos = u.rtl * 256 + h * 128 + R_; const int tok = pos < ce ? (list[(size_t)u.e * T_TOK + pos] >> 2) : 0;
                out[h][i] = (unsigned)(tok * K + C_) * 2u; } }
    }
    __device__ __forceinline__ void a_ready(const Unit&) const {}
    __device__ __forceinline__ void done(const Unit&) const {}
};
constexpr int UT_OFF = 131072, UT_MAXU = 24, UT_TOK_OFF = UT_OFF + 1024;
struct TableOrder {
    const volatile PG8_LAS int* tab; const volatile PG8_LAS int* toks; int n;
    __device__ __forceinline__ bool next(int i, Unit& u) const {
        if (i >= n) return false;
        u.pm = __builtin_amdgcn_readfirstlane(tab[i * 8]); u.pn = __builtin_amdgcn_readfirstlane(tab[i * 8 + 1]); u.e = __builtin_amdgcn_readfirstlane(tab[i * 8 + 2]);
        u.pnl = __builtin_amdgcn_readfirstlane(tab[i * 8 + 3]); u.rtl = __builtin_amdgcn_readfirstlane(tab[i * 8 + 4]); u.ui = i; return true;
    }
    __device__ __forceinline__ void gather(const Unit& u, int tid, int K, unsigned (&out)[2][2]) const {
#pragma unroll
        for (int i = 0; i < 2; ++i) { int R_, C_; stage_rc(tid * 16 + i * 8192, R_, C_);
#pragma unroll
            for (int h = 0; h < 2; ++h) { const int row = toks ? toks[u.ui * 256 + h * 128 + R_] : u.pm * 256 + h * 128 + R_; out[h][i] = (unsigned)(row * K + C_) * 2u; } }
    }
    __device__ __forceinline__ void a_ready(const Unit&) const {}
    __device__ __forceinline__ void done(const Unit&) const {}
};
struct EpiMlp1 {
    static constexpr bool PERM = true, AFTER_DRAIN = false, MIDK = false;
    const float* b1; bf16_t* act;
    __device__ __forceinline__ void operator()(const f32x4 (&acc)[2][2][4][2], const Unit& u, int wr, int wc, int fr, int fq) const {
        const int row0 = u.pm * BM + wr * 64 + fr, j0 = u.pnl * 128 + wc * 32 + 8 * fq;
        const float4* bp = (const float4*)(b1 + (size_t)u.e * 2048 + j0);
        const float4 bg0 = bp[0], bg1 = bp[1], bl0 = bp[256], bl1 = bp[257];
        const float bg[8] = {bg0.x, bg0.y, bg0.z, bg0.w, bg1.x, bg1.y, bg1.z, bg1.w}, bl[8] = {bl0.x, bl0.y, bl0.z, bl0.w, bl1.x, bl1.y, bl1.z, bl1.w};
#pragma unroll
        for (int ai = 0; ai < 2; ++ai)
#pragma unroll
            for (int m = 0; m < 4; ++m) {
                float o[8];
#pragma unroll
                for (int n = 0; n < 2; ++n)
#pragma unroll
                    for (int e = 0; e < 4; ++e) {
                        const float gl = fminf(acc[ai][0][m][n][e] + bg[4 * n + e], 7.f);
                        const float li = fminf(fmaxf(acc[ai][1][m][n][e] + bl[4 * n + e], -7.f), 7.f);
                        o[4 * n + e] = gl * __builtin_amdgcn_rcpf(1.f + __expf(-1.702f * gl)) * (li + 1.f); }
                if (MOE2_FP8) {
                    int p0 = __builtin_amdgcn_cvt_pk_fp8_f32(o[0], o[1], 0, false); p0 = __builtin_amdgcn_cvt_pk_fp8_f32(o[2], o[3], p0, true);
                    int p1 = __builtin_amdgcn_cvt_pk_fp8_f32(o[4], o[5], 0, false); p1 = __builtin_amdgcn_cvt_pk_fp8_f32(o[6], o[7], p1, true);
                    *(uint2*)((unsigned char*)act + (size_t)(row0 + ai * HALF + m * 16) * 1024 + j0) = make_uint2((unsigned)p0, (unsigned)p1);
                } else {
                u32x4 w; w.x = cvt_pk_bf16(o[0], o[1]); w.y = cvt_pk_bf16(o[2], o[3]); w.z = cvt_pk_bf16(o[4], o[5]); w.w = cvt_pk_bf16(o[6], o[7]);
                *(u32x4*)(act + (size_t)(row0 + ai * HALF + m * 16) * 1024 + j0) = w; }
            }
    }
};
constexpr bool Y_FP8 = true;
struct EpiMlp2 {
    static constexpr bool PERM = true, AFTER_DRAIN = false, MIDK = false;
    const float* b2; bf16_t* y; const volatile PG8_LAS int* dest;
    __device__ __forceinline__ void operator()(const f32x4 (&acc)[2][2][4][2], const Unit& u, int wr, int wc, int fr, int fq) const {
        const int r0 = wr * 64 + fr, c0 = Y_FP8 ? u.pnl * 256 + wc * 64 + 16 * fq : u.pnl * 256 + wc * 32 + 8 * fq;
        const volatile PG8_LAS int* lp = dest + u.ui * 256;
        f32x4 bv[2][2];
#pragma unroll
        for (int bj = 0; bj < 2; ++bj)
#pragma unroll
            for (int n = 0; n < 2; ++n) bv[bj][n] = *(const f32x4*)(b2 + (size_t)u.e * 1024 + c0 + (Y_FP8 ? bj * 8 : bj * HALF) + 4 * n);
#pragma unroll
        for (int ai = 0; ai < 2; ++ai)
#pragma unroll
            for (int m = 0; m < 4; ++m) { const int r = r0 + ai * HALF + m * 16;
                const int dr = lp[r];
                if (dr >= 0) {
                    if (Y_FP8) { unsigned char* rowp = (unsigned char*)y + (size_t)dr * 1024 + c0;
                        unsigned pk[4];
#pragma unroll
                        for (int bj = 0; bj < 2; ++bj) { const f32x4 v0 = acc[ai][bj][m][0] + bv[bj][0], v1 = acc[ai][bj][m][1] + bv[bj][1];
                            int p0 = __builtin_amdgcn_cvt_pk_fp8_f32(v0[0], v0[1], 0, false); p0 = __builtin_amdgcn_cvt_pk_fp8_f32(v0[2], v0[3], p0, true);
                            int p1 = __builtin_amdgcn_cvt_pk_fp8_f32(v1[0], v1[1], 0, false); p1 = __builtin_amdgcn_cvt_pk_fp8_f32(v1[2], v1[3], p1, true);
                            pk[2 * bj] = (unsigned)p0; pk[2 * bj + 1] = (unsigned)p1; }
                        *(u32x4*)rowp = (u32x4){pk[0], pk[1], pk[2], pk[3]};
                    } else { bf16_t* rowp = y + (size_t)dr * 1024 + c0;
#pragma unroll
                    for (int bj = 0; bj < 2; ++bj) { const f32x4 v0 = acc[ai][bj][m][0] + bv[bj][0], v1 = acc[ai][bj][m][1] + bv[bj][1];
                        u32x4 w; w.x = cvt_pk_bf16(v0[0], v0[1]); w.y = cvt_pk_bf16(v0[2], v0[3]); w.z = cvt_pk_bf16(v1[0], v1[1]); w.w = cvt_pk_bf16(v1[2], v1[3]);
                        *(u32x4*)(rowp + bj * HALF) = w; } } } }
    }
};
}

typedef __bf16 bf2v __attribute__((ext_vector_type(2)));
struct HRows { v4u v[32]; };
__device__ __forceinline__ void hrows_load(HRows& R, const bf16_t* src, int row0, int lane) {
    const bf16_t* xr = src + (size_t)(row0 + (lane & 15)) * DM + 16 * (lane >> 4);
#pragma unroll
    for (int j = 0; j < 16; ++j) { R.v[2 * j] = *(const v4u*)(xr + 64 * j); R.v[2 * j + 1] = *(const v4u*)(xr + 64 * j + 8); }
}
__device__ __forceinline__ void router_round_regs(const Frame& F, int bt, bool valid, const HRows& R, const float* wn, const LAS bf16_t* whi, const LAS bf16_t* wlo, LAS float* lgs, LAS int* hist, LAS int* hbase,
                                                  const float* br, unsigned char* xn2, int* cnt, int* asg_e, int* asg_pos, float* asg_g, int* list) {
    const int lane = F.lane, row0 = bt * 16;
    int ti[4] = {0, 0, 0, 0}, lpos[4] = {0, 0, 0, 0}; float gq[4] = {0.f, 0.f, 0.f, 0.f};
    if (F.tid < 32) hist[F.tid] = 0;
    __syncthreads();
    if (valid) {
        const int r = lane & 15, kq = lane >> 4;
        f32x4v acc[2] = {(f32x4v){0.f, 0.f, 0.f, 0.f}, (f32x4v){0.f, 0.f, 0.f, 0.f}}; float ssp = 0.f;
#pragma unroll
        for (int s = 0; s < 32; ++s) {
            const v4u hv = R.v[s];
#pragma unroll
            for (int q = 0; q < 4; ++q) { const float a = __uint_as_float(hv[q] << 16), b = __uint_as_float(hv[q] & 0xffff0000u); ssp += a * a + b * b; }
            const bf16x8 ah = __builtin_bit_cast(bf16x8, hv);
#pragma unroll
            for (int h = 0; h < 2; ++h) {
                const int ko = 64 * (s >> 1) + 16 * kq + 8 * (s & 1);
                const bf16x8 bh = *(const LAS bf16x8*)(whi + (16 * h + r) * WR_PITCH + ko), bl = *(const LAS bf16x8*)(wlo + (16 * h + r) * WR_PITCH + ko);
                acc[h] = __builtin_amdgcn_mfma_f32_16x16x32_bf16(ah, bh, acc[h], 0, 0, 0);
                acc[h] = __builtin_amdgcn_mfma_f32_16x16x32_bf16(ah, bl, acc[h], 0, 0, 0);
            }
            if ((s & 3) == 3) __builtin_amdgcn_sched_barrier(0);
        }
        ssp += __shfl_xor(ssp, 16); ssp += __shfl_xor(ssp, 32);
        const float rs = rsqrtf(ssp * (1.f / DM) + EPS);
        {
            const float* wp = wn + 16 * kq; unsigned char* dp = xn2 + (size_t)(row0 + r) * DM + 16 * kq;
#pragma unroll
            for (int j = 0; j < 16; ++j) {
                unsigned pk[4];
#pragma unroll
                for (int o = 0; o < 2; ++o) {
                    v4u hv = R.v[2 * j + o]; const f32x4v w0 = *(const f32x4v*)(wp + 64 * j + 8 * o), w1 = *(const f32x4v*)(wp + 64 * j + 8 * o + 4);
                    asm volatile("" : "+v"(hv));
                    const float y0 = __uint_as_float(hv.x << 16) * rs * w0[0], y1 = __uint_as_float(hv.x & 0xffff0000u) * rs * w0[1], y2 = __uint_as_float(hv.y << 16) * rs * w0[2], y3 = __uint_as_float(hv.y & 0xffff0000u) * rs * w0[3];
                    const float y4 = __uint_as_float(hv.z << 16) * rs * w1[0], y5 = __uint_as_float(hv.z & 0xffff0000u) * rs * w1[1], y6 = __uint_as_float(hv.w << 16) * rs * w1[2], y7 = __uint_as_float(hv.w & 0xffff0000u) * rs * w1[3];
                    int p0 = __builtin_amdgcn_cvt_pk_fp8_f32(y0, y1, 0, false); p0 = __builtin_amdgcn_cvt_pk_fp8_f32(y2, y3, p0, true);
                    int p1 = __builtin_amdgcn_cvt_pk_fp8_f32(y4, y5, 0, false); p1 = __builtin_amdgcn_cvt_pk_fp8_f32(y6, y7, p1, true);
                    pk[2 * o] = (unsigned)p0; pk[2 * o + 1] = (unsigned)p1;
                }
                *(v4u*)(dp + 64 * j) = (v4u){pk[0], pk[1], pk[2], pk[3]};
                __builtin_amdgcn_sched_barrier(0);
            }
        }
        const int n = lane & 15, m0 = 4 * (lane >> 4);
        const float b0 = br[n], b1 = br[16 + n];
#pragma unroll
        for (int i = 0; i < 4; ++i) { const float rsm = __shfl(rs, m0 + i); lgs[(m0 + i) * 32 + n] = acc[0][i] * rsm + b0; lgs[(m0 + i) * 32 + 16 + n] = acc[1][i] * rsm + b1; }
        asm volatile("s_waitcnt lgkmcnt(0)" ::: "memory");
        if (lane < 16) {
            float lg[32];
#pragma unroll
            for (int q = 0; q < 8; ++q) { const f32x4v t = *(const LAS f32x4v*)(lgs + lane * 32 + 4 * q); lg[4 * q] = t[0]; lg[4 * q + 1] = t[1]; lg[4 * q + 2] = t[2]; lg[4 * q + 3] = t[3]; }
            float tv[4];
#pragma unroll
            for (int k = 0; k < 4; ++k) {
                float bv = -INFINITY; int bi = 0;
#pragma unroll
                for (int e = 0; e < 32; ++e) if (lg[e] > bv) { bv = lg[e]; bi = e; }
#pragma unroll
                for (int e = 0; e < 32; ++e) if (e == bi) lg[e] = -INFINITY;
                tv[k] = bv; ti[k] = bi;
            }
            const float e1 = __expf(tv[1] - tv[0]), e2 = __expf(tv[2] - tv[0]), e3 = __expf(tv[3] - tv[0]); const float inv = 1.f / (1.f + e1 + e2 + e3);
            gq[0] = inv; gq[1] = e1 * inv; gq[2] = e2 * inv; gq[3] = e3 * inv;
#pragma unroll
            for (int k = 0; k < 4; ++k) lpos[k] = atomicAdd((int*)(hist + ti[k]), 1);
        }
    }
    __syncthreads();
    if (F.tid < 32) { const int c = hist[F.tid]; hbase[F.tid] = c ? atomicAdd(&cnt[F.tid * CNT_STRIDE], c) : 0; }
    __syncthreads();
    if (valid && lane < 16) {
        const int row = row0 + lane; int pos[4];
#pragma unroll
        for (int k = 0; k < 4; ++k) pos[k] = hbase[ti[k]] + lpos[k];
        *(int4*)(asg_e + row * 4) = make_int4(ti[0], ti[1], ti[2], ti[3]);
        *(int4*)(asg_pos + row * 4) = make_int4(pos[0], pos[1], pos[2], pos[3]);
        *(float4*)(asg_g + row * 4) = make_float4(gq[0], gq[1], gq[2], gq[3]);
#pragma unroll
        for (int k = 0; k < 4; ++k) list[(size_t)ti[k] * T_TOK + pos[k]] = row * 4 + k;
    }
}
__device__ __forceinline__ void router_round(const Frame& F, int bt, bool valid, const float* hbuf, const float* wn, const LAS bf16_t* whi, const LAS bf16_t* wlo, LAS float* lgs, LAS int* hist, LAS int* hbase,
                                             const float* br, bf16_t* xn2, int* cnt, int* asg_e, int* asg_pos, float* asg_g, int* list) {
    const int lane = F.lane, row0 = bt * 16;
    float rs = 0.f; int ti[4] = {0, 0, 0, 0}, lpos[4] = {0, 0, 0, 0}; float gq[4] = {0.f, 0.f, 0.f, 0.f};
    if (F.tid < 32) hist[F.tid] = 0;
    __syncthreads();
    if (valid) {
        f32x4v acc[2];
        if (H_BF16) rowproj_batch_bf<2>((const bf16_t*)hbuf, row0, lane, whi, wlo, acc, rs); else rowproj_batch<2>(hbuf, row0, lane, whi, wlo, acc, rs);
        const int n = lane & 15, m0 = 4 * (lane >> 4);
        const float b0 = br[n], b1 = br[16 + n];
#pragma unroll
        for (int i = 0; i < 4; ++i) { const float rsm = __shfl(rs, m0 + i); lgs[(m0 + i) * 32 + n] = acc[0][i] * rsm + b0; lgs[(m0 + i) * 32 + 16 + n] = acc[1][i] * rsm + b1; }
        asm volatile("s_waitcnt lgkmcnt(0)" ::: "memory");
        if (lane < 16) {
            float lg[32];
#pragma unroll
            for (int q = 0; q < 8; ++q) { const f32x4v t = *(const LAS f32x4v*)(lgs + lane * 32 + 4 * q); lg[4 * q] = t[0]; lg[4 * q + 1] = t[1]; lg[4 * q + 2] = t[2]; lg[4 * q + 3] = t[3]; }
            float tv[4];
#pragma unroll
            for (int k = 0; k < 4; ++k) {
                float bv = -INFINITY; int bi = 0;
#pragma unroll
                for (int e = 0; e < 32; ++e) if (lg[e] > bv) { bv = lg[e]; bi = e; }
#pragma unroll
                for (int e = 0; e < 32; ++e) if (e == bi) lg[e] = -INFINITY;
                tv[k] = bv; ti[k] = bi;
            }
            const float e1 = __expf(tv[1] - tv[0]), e2 = __expf(tv[2] - tv[0]), e3 = __expf(tv[3] - tv[0]); const float inv = 1.f / (1.f + e1 + e2 + e3);
            gq[0] = inv; gq[1] = e1 * inv; gq[2] = e2 * inv; gq[3] = e3 * inv;
#pragma unroll
            for (int k = 0; k < 4; ++k) lpos[k] = atomicAdd((int*)(hist + ti[k]), 1);
        }
    }
    __syncthreads();
    if (F.tid < 32) { const int c = hist[F.tid]; hbase[F.tid] = c ? atomicAdd(&cnt[F.tid * CNT_STRIDE], c) : 0; }
    __syncthreads();
    if (valid) {
        if (lane < 16) {
            const int row = row0 + lane; int pos[4];
#pragma unroll
            for (int k = 0; k < 4; ++k) pos[k] = hbase[ti[k]] + lpos[k];
            *(int4*)(asg_e + row * 4) = make_int4(ti[0], ti[1], ti[2], ti[3]);
            *(int4*)(asg_pos + row * 4) = make_int4(pos[0], pos[1], pos[2], pos[3]);
            *(float4*)(asg_g + row * 4) = make_float4(gq[0], gq[1], gq[2], gq[3]);
#pragma unroll
            for (int k = 0; k < 4; ++k) list[(size_t)ti[k] * T_TOK + pos[k]] = row * 4 + k;
        }
        if (H_BF16) write_norm_rows_f8_bf((const bf16_t*)hbuf, (unsigned char*)xn2, row0, lane, rs, wn);
        else if (MOE1_FP8) write_norm_rows_f8(hbuf, (unsigned char*)xn2, row0, lane, rs, wn); else write_norm_rows(hbuf, xn2, row0, lane, rs, wn);
    }
}
__device__ __forceinline__ void final_row(int row, int lane, const bf16_t* hbuf, const bf16_t* y, const float* asg_g, const float* wf, float* out, float dscale) {
    const float4 gv = *(const float4*)(asg_g + row * 4);
    v4u hq[2], y0[2], y1[2], y2[2], y3[2];
    const bf16_t* yr = y + (size_t)row * 4 * DM;
#pragma unroll
    for (int j = 0; j < 2; ++j) { const int c = 8 * (lane + 64 * j);
        hq[j] = __builtin_nontemporal_load((const v4u*)(hbuf + (size_t)row * DM + c));
        y0[j] = __builtin_nontemporal_load((const v4u*)(yr + c)); y1[j] = __builtin_nontemporal_load((const v4u*)(yr + DM + c)); y2[j] = __builtin_nontemporal_load((const v4u*)(yr + 2 * DM + c)); y3[j] = __builtin_nontemporal_load((const v4u*)(yr + 3 * DM + c)); }
    float v[2][8]; float ss = 0.f;
#pragma unroll
    for (int j = 0; j < 2; ++j)
#pragma unroll
        for (int q = 0; q < 4; ++q) {
            float a = __uint_as_float(hq[j][q] << 16), b = __uint_as_float(hq[j][q] & 0xffff0000u);
            a += gv.x * __uint_as_float(y0[j][q] << 16) + gv.y * __uint_as_float(y1[j][q] << 16) + gv.z * __uint_as_float(y2[j][q] << 16) + gv.w * __uint_as_float(y3[j][q] << 16);
            b += gv.x * __uint_as_float(y0[j][q] & 0xffff0000u) + gv.y * __uint_as_float(y1[j][q] & 0xffff0000u) + gv.z * __uint_as_float(y2[j][q] & 0xffff0000u) + gv.w * __uint_as_float(y3[j][q] & 0xffff0000u);
            v[j][2 * q] = a; v[j][2 * q + 1] = b; ss += a * a + b * b; }
    ss = wave_sum(ss); const float rs = rsqrtf(ss * (1.f / DM) + EPS) * dscale;
#pragma unroll
    for (int j = 0; j < 2; ++j) { const int c = 8 * (lane + 64 * j); const float4 w0 = *(const float4*)(wf + c), w1 = *(const float4*)(wf + c + 4);
        __builtin_nontemporal_store((f32x4v){v[j][0] * rs * w0.x, v[j][1] * rs * w0.y, v[j][2] * rs * w0.z, v[j][3] * rs * w0.w}, (f32x4v*)(out + (size_t)row * DM + c));
        __builtin_nontemporal_store((f32x4v){v[j][4] * rs * w1.x, v[j][5] * rs * w1.y, v[j][6] * rs * w1.z, v[j][7] * rs * w1.w}, (f32x4v*)(out + (size_t)row * DM + c + 4)); }
}
typedef float f32x2v __attribute__((ext_vector_type(2)));
__device__ __forceinline__ void final_row_f8(int row, int lane, const bf16_t* hbuf, const unsigned char* y8, const float* asg_g, const f32x4v (&wfv)[4], float* out, float dscale, LAS float* tile) {
    const float4 gv = *(const float4*)(asg_g + row * 4);
    const unsigned char* yr = y8 + (size_t)row * 4 * DM + 16 * lane;
    const v4u ya = *(const v4u*)yr, yb = *(const v4u*)(yr + DM), yc = *(const v4u*)(yr + 2 * DM), yd = *(const v4u*)(yr + 3 * DM);
    const v4u h0 = *(const v4u*)(hbuf + (size_t)row * DM + 16 * lane), h1 = *(const v4u*)(hbuf + (size_t)row * DM + 16 * lane + 8);
    float ss = 0.f;
#pragma unroll
    for (int q = 0; q < 4; ++q) {
        const f32x2v a0 = __builtin_amdgcn_cvt_pk_f32_fp8((int)ya[q], false), a1 = __builtin_amdgcn_cvt_pk_f32_fp8((int)ya[q], true);
        const f32x2v b0 = __builtin_amdgcn_cvt_pk_f32_fp8((int)yb[q], false), b1 = __builtin_amdgcn_cvt_pk_f32_fp8((int)yb[q], true);
        const f32x2v c0 = __builtin_amdgcn_cvt_pk_f32_fp8((int)yc[q], false), c1 = __builtin_amdgcn_cvt_pk_f32_fp8((int)yc[q], true);
        const f32x2v d0 = __builtin_amdgcn_cvt_pk_f32_fp8((int)yd[q], false), d1 = __builtin_amdgcn_cvt_pk_f32_fp8((int)yd[q], true);
        const unsigned hw0 = (q < 2) ? h0[2 * q] : h1[2 * q - 4], hw1 = (q < 2) ? h0[2 * q + 1] : h1[2 * q - 3];
        f32x4v v;
        v[0] = __uint_as_float(hw0 << 16) + gv.x * a0[0] + gv.y * b0[0] + gv.z * c0[0] + gv.w * d0[0];
        v[1] = __uint_as_float(hw0 & 0xffff0000u) + gv.x * a0[1] + gv.y * b0[1] + gv.z * c0[1] + gv.w * d0[1];
        v[2] = __uint_as_float(hw1 << 16) + gv.x * a1[0] + gv.y * b1[0] + gv.z * c1[0] + gv.w * d1[0];
        v[3] = __uint_as_float(hw1 & 0xffff0000u) + gv.x * a1[1] + gv.y * b1[1] + gv.z * c1[1] + gv.w * d1[1];
        ss += (v[0] * v[0] + v[1] * v[1]) + (v[2] * v[2] + v[3] * v[3]);
        *(LAS f32x4v*)(tile + 16 * lane + 4 * q) = v;
    }
    ss = wave_sum(ss); const float rs = rsqrtf(ss * (1.f / DM) + EPS) * dscale;
    asm volatile("s_waitcnt lgkmcnt(0)" ::: "memory");
#pragma unroll
    for (int q = 0; q < 4; ++q) { const f32x4v v = *(const LAS f32x4v*)(tile + 256 * q + 4 * lane), w = wfv[q];
        pg8::st16_wt(out + (size_t)row * DM + 256 * q + 4 * lane, __builtin_bit_cast(pg8::u32x4, v * rs * w)); }
    asm volatile("s_waitcnt lgkmcnt(0)" ::: "memory");
}
__device__ __forceinline__ void moe_prefix(const Frame& F, const int* cnt, volatile LAS int* tp) {
    __syncthreads();
    if (F.wave == 0) {
        const int t = F.lane < 32 ? (cnt[(F.lane & 31) * CNT_STRIDE] + 255) >> 8 : 0;
        int inc = t;
#pragma unroll
        for (int o = 1; o < 32; o <<= 1) { const int v = __shfl_up(inc, o); if (F.lane >= o) inc += v; }
        if (F.lane < 32) tp[F.lane] = inc - t;
        if (F.lane == 31) tp[32] = inc;
    }
    __syncthreads();
}
namespace pg8 {
template <bool SECOND> struct EpiBranch {
    static constexpr bool PERM = true, AFTER_DRAIN = false, MIDK = false;
    const unsigned char* gate; bf16_t* merged;
    __device__ __forceinline__ void operator()(const f32x4 (&acc)[2][2][4][2], const Unit& u, int wr, int wc, int fr, int fq) const {
        const int row0 = u.pm * BM + wr * 64 + fr, c0 = u.pn * 256 + wc * 32 + 8 * fq, g0 = u.pn * 256 + wc * 64 + 16 * fq;
#pragma unroll
        for (int ai = 0; ai < 2; ++ai) {
            u32x4 g4[4], pv[4][2];
#pragma unroll
            for (int m = 0; m < 4; ++m) { const size_t roff = (size_t)(row0 + ai * HALF + m * 16) * 1024;
                g4[m] = *(const u32x4*)(gate + roff + g0);
                if (SECOND) { pv[m][0] = *(const u32x4*)(merged + roff + c0); pv[m][1] = *(const u32x4*)(merged + roff + c0 + HALF); } }
#pragma unroll
            for (int m = 0; m < 4; ++m) { const size_t off = (size_t)(row0 + ai * HALF + m * 16) * 1024 + c0;
#pragma unroll
                for (int bj = 0; bj < 2; ++bj) {
                    const unsigned gx = g4[m][2 * bj], gy = g4[m][2 * bj + 1];
                    float o[8];
#pragma unroll
                    for (int e = 0; e < 4; ++e) { o[e] = (float)((gx >> (8 * e)) & 0xffu) * (1.f / 255.f) * acc[ai][bj][m][0][e]; o[4 + e] = (float)((gy >> (8 * e)) & 0xffu) * (1.f / 255.f) * acc[ai][bj][m][1][e]; }
                    if (SECOND) {
#pragma unroll
                        for (int q = 0; q < 4; ++q) { o[2 * q] += __uint_as_float(pv[m][bj][q] << 16); o[2 * q + 1] += __uint_as_float(pv[m][bj][q] & 0xffff0000u); } }
                    u32x4 w; w.x = cvt_pk_bf16(o[0], o[1]); w.y = cvt_pk_bf16(o[2], o[3]); w.z = cvt_pk_bf16(o[4], o[5]); w.w = cvt_pk_bf16(o[6], o[7]);
                    *(u32x4*)(merged + off + bj * HALF) = w; } }
        }
    }
};
struct EpiOutRes {
    static constexpr bool PERM = true, AFTER_DRAIN = false, MIDK = false;
    const float* x; bf16_t* h;
    __device__ __forceinline__ void operator()(const f32x4 (&acc)[2][2][4][2], const Unit& u, int wr, int wc, int fr, int fq) const {
        const int row0 = u.pm * BM + wr * 64 + fr, c0 = u.pn * 256 + wc * 32 + 8 * fq;
#pragma unroll
        for (int ai = 0; ai < 2; ++ai) {
            f32x4 xv[4][2][2];
#pragma unroll
            for (int m = 0; m < 4; ++m)
#pragma unroll
                for (int bj = 0; bj < 2; ++bj) { const size_t off = (size_t)(row0 + ai * HALF + m * 16) * 1024 + c0 + bj * HALF;
                    xv[m][bj][0] = *(const f32x4*)(x + off); xv[m][bj][1] = *(const f32x4*)(x + off + 4); }
#pragma unroll
            for (int m = 0; m < 4; ++m)
#pragma unroll
                for (int bj = 0; bj < 2; ++bj) { const size_t off = (size_t)(row0 + ai * HALF + m * 16) * 1024 + c0 + bj * HALF;
                    const f32x4 v0 = xv[m][bj][0] + acc[ai][bj][m][0], v1 = xv[m][bj][1] + acc[ai][bj][m][1];
                    u32x4 w; w.x = cvt_pk_bf16(v0[0], v0[1]); w.y = cvt_pk_bf16(v0[2], v0[3]); w.z = cvt_pk_bf16(v1[0], v1[1]); w.w = cvt_pk_bf16(v1[2], v1[3]);
                    *(u32x4*)(h + off) = w; }
        }
    }
};
}

__device__ __forceinline__ int moe_build_tables(const Frame& F, const pg8::GroupedOrder& S, int mode, const int* list) {
    LAS int* tab = (LAS int*)(F.lds + pg8::UT_OFF); LAS int* toks = (LAS int*)(F.lds + pg8::UT_TOK_OFF);
    const int need = (S.nwg + S.G - 1) / S.G;
    if (need > pg8::UT_MAXU) return -1;
    __syncthreads();
    if (F.wave == 0) {
        int pm = 0, pn = 0, e = 0, rtl = 0; const bool ok = F.lane < pg8::UT_MAXU && S.next_lane(F.lane, pm, pn, e, rtl);
        if (ok) { tab[F.lane * 8] = pm; tab[F.lane * 8 + 1] = e * S.nN + pn; tab[F.lane * 8 + 2] = e; tab[F.lane * 8 + 3] = pn; tab[F.lane * 8 + 4] = rtl; }
        const int n = __popcll(__ballot(ok)); if (F.lane == 0) tab[pg8::UT_MAXU * 8] = n;
    }
    __syncthreads();
    const int n = tab[pg8::UT_MAXU * 8];
    if (mode) {
        for (int base = F.tid; base < n * 256; base += 4 * NWAVES * 64) {
            int v[4]; bool in[4];
#pragma unroll
            for (int q = 0; q < 4; ++q) { const int idx = min(base + q * NWAVES * 64, n * 256 - 1), ui = idx >> 8, r = idx & 255, e = tab[ui * 8 + 2], pos = tab[ui * 8 + 4] * 256 + r;
                const int c = S.cnt[e * CNT_STRIDE]; in[q] = pos < c; v[q] = list[(size_t)e * T_TOK + (in[q] ? pos : 0)]; }
#pragma unroll
            for (int q = 0; q < 4; ++q) { const int idx = base + q * NWAVES * 64; if (idx < n * 256) toks[idx] = mode == 1 ? (in[q] ? (v[q] >> 2) : 0) : (in[q] ? v[q] : -1); }
        }
        __syncthreads();
    }
    return n;
}
constexpr int ML = 256, MUNITS = 512;
constexpr int KT_PITCH = 264;
constexpr int KR_PITCH = 136;
constexpr int P2_KT = 0, P2_VT = 67584, P2_SC = 135168;
constexpr int P4_K = 0, P4_VT = 69632, P4_SC = 137216;
constexpr float LOG2E = 1.4426950408889634f;
typedef unsigned u32x2v __attribute__((ext_vector_type(2)));

__device__ __forceinline__ unsigned cvtpk(float lo, float hi) { typedef float f2v_ __attribute__((ext_vector_type(2))); typedef __bf16 b2v_ __attribute__((ext_vector_type(2)));
    const f2v_ v = {lo, hi}; return __builtin_bit_cast(unsigned, __builtin_convertvector(v, b2v_)); }
__device__ __forceinline__ float bflo(unsigned u) { return __uint_as_float(u << 16); }
__device__ __forceinline__ float bfhi(unsigned u) { return __uint_as_float(u & 0xffff0000u); }
__device__ __forceinline__ int kpos(int key) { return (key & ~12) | ((key & 4) << 1) | ((key & 8) >> 1); }

__device__ __forceinline__ void stage_vt(const bf16_t* V, size_t row0, int col0, LAS unsigned char* vt, int tid) {
    const int rg = tid >> 4, cg = tid & 15;
    v4u rows[8];
#pragma unroll
    for (int r = 0; r < 8; ++r) rows[r] = *(const v4u*)(V + (row0 + rg * 8 + r) * 512 + col0 + cg * 8);
    const int g = rg >> 1, a = rg & 1;
#pragma unroll
    for (int e = 0; e < 8; ++e) {
        unsigned short x[8];
#pragma unroll
        for (int r = 0; r < 8; ++r) { const unsigned w = rows[r][e >> 1]; x[r] = (e & 1) ? (unsigned short)(w >> 16) : (unsigned short)(w & 0xffffu); }
        LAS unsigned char* p = vt + (cg * 8 + e) * (KT_PITCH * 2); const int b1 = (16 * g + 4 * a) * 2, sw = (cg & 15) << 4;
        *(LAS u32x2v*)(p + (b1 ^ sw)) = (u32x2v){(unsigned)x[0] | ((unsigned)x[1] << 16), (unsigned)x[2] | ((unsigned)x[3] << 16)};
        *(LAS u32x2v*)(p + ((b1 + 16) ^ sw)) = (u32x2v){(unsigned)x[4] | ((unsigned)x[5] << 16), (unsigned)x[6] | ((unsigned)x[7] << 16)};
    }
}

struct MlstmBufs { const bf16_t *MQ, *MK, *MV, *MO; const float* gates; const float *cw, *cb, *hw; bf16_t *MQc, *MKc; float* G; bf16_t* Cst; float *AB, *NV, *NST, *DC; bf16_t* Ym; };

__device__ __forceinline__ void mlstm_p2_unit(const Frame& F, const MlstmBufs& M, int u) {
    const int b = u >> 6, h = (u >> 4) & 3, c = u & 15, tid = F.tid;
    const size_t row0 = (size_t)b * SEQ + c * ML;
    LAS float* sA = (LAS float*)(F.lds + P2_SC); LAS float* sB = sA + 256; LAS float* sW = sA + 512; LAS float* sNV = sA + 1024; LAS float* sX = sA + 896;
    float fc = 0.f, ip = 0.f;
    if (tid < 256) {
        ip = M.gates[(row0 + tid) * 8 + h]; const float fp = M.gates[(row0 + tid) * 8 + 4 + h];
        fc = -log1pf(__expf(-fp));
#pragma unroll
        for (int o = 1; o < 64; o <<= 1) { const float t = __shfl_up(fc, o); if (F.lane >= o) fc += t; }
        if (F.lane == 63) sX[F.wave] = fc;
    }
    __syncthreads();
    if (tid < 256) {
        float off = 0.f;
#pragma unroll
        for (int w = 0; w < 4; ++w) if (w < F.wave) off += sX[w];
        fc += off;
        const float fend = sX[0] + sX[1] + sX[2] + sX[3];
        const float A = fc * LOG2E, B = (fc - ip) * LOG2E;
        sA[tid] = A; sB[tid] = B; sW[tid] = __expf(fend - fc + ip);
        *(float2*)(M.AB + ((row0 + tid) * 4 + h) * 2) = make_float2(A, B);
        if (tid == 0) M.DC[u] = __expf(fend);
    }
    __syncthreads();
    const int rg = tid >> 4, cg = tid & 15, ch0 = h * 128 + cg * 8;
    const int g = rg >> 1, a = rg & 1;
    v4u raws[2][11];
#pragma unroll
    for (int isk = 0; isk < 2; ++isk) { const bf16_t* src = isk ? M.MK : M.MQ;
#pragma unroll
        for (int i = 0; i < 11; ++i) { const int s = c * ML + rg * 8 - 3 + i;
            raws[isk][i] = (s >= 0) ? *(const v4u*)(src + ((size_t)b * SEQ + s) * 512 + ch0) : (v4u){0u, 0u, 0u, 0u}; } }
#pragma unroll
    for (int isk = 0; isk < 2; ++isk) {
        bf16_t* dst = isk ? M.MKc : M.MQc;
        float w[4][8], bias[8];
#pragma unroll
        for (int j = 0; j < 4; ++j) { const float4 p = *(const float4*)(M.cw + j * 1024 + isk * 512 + ch0), q = *(const float4*)(M.cw + j * 1024 + isk * 512 + ch0 + 4);
            w[j][0] = p.x; w[j][1] = p.y; w[j][2] = p.z; w[j][3] = p.w; w[j][4] = q.x; w[j][5] = q.y; w[j][6] = q.z; w[j][7] = q.w; }
        { const float4 p = *(const float4*)(M.cb + isk * 512 + ch0), q = *(const float4*)(M.cb + isk * 512 + ch0 + 4);
            bias[0] = p.x; bias[1] = p.y; bias[2] = p.z; bias[3] = p.w; bias[4] = q.x; bias[5] = q.y; bias[6] = q.z; bias[7] = q.w; }
        const v4u (&raw)[11] = raws[isk];
        float nvp[8];
#pragma unroll
        for (int e = 0; e < 8; ++e) nvp[e] = 0.f;
        unsigned ktp[8][4];
#pragma unroll
        for (int rp = 0; rp < 4; ++rp) {
            float kw[2][8];
#pragma unroll
            for (int rr = 0; rr < 2; ++rr) {
                const int r = 2 * rp + rr;
                float y[8];
#pragma unroll
                for (int e = 0; e < 8; ++e) { float s = bias[e];
#pragma unroll
                    for (int j = 0; j < 4; ++j) { const unsigned wd = raw[r + j][e >> 1]; s += w[j][e] * ((e & 1) ? bfhi(wd) : bflo(wd)); }
                    s = s * __builtin_amdgcn_rcpf(1.f + __expf(-s)); y[e] = isk ? s * 0.08838834764831845f : s; }
                v4u o; o.x = cvtpk(y[0], y[1]); o.y = cvtpk(y[2], y[3]); o.z = cvtpk(y[4], y[5]); o.w = cvtpk(y[6], y[7]);
                *(v4u*)(dst + (row0 + rg * 8 + r) * 512 + ch0) = o;
                if (isk) { const float ws = sW[rg * 8 + r];
#pragma unroll
                    for (int e = 0; e < 8; ++e) { kw[rr][e] = y[e] * ws; nvp[e] += kw[rr][e]; } }
            }
            if (isk) {
#pragma unroll
                for (int e = 0; e < 8; ++e) ktp[e][rp] = cvtpk(kw[0][e], kw[1][e]);
            }
        }
        if (isk) {
#pragma unroll
            for (int e = 0; e < 8; ++e) {
                LAS unsigned char* p = F.lds + P2_KT + (cg * 8 + e) * (KT_PITCH * 2); const int b1 = (16 * g + 4 * a) * 2, sw = (cg & 15) << 4;
                *(LAS u32x2v*)(p + (b1 ^ sw)) = (u32x2v){ktp[e][0], ktp[e][1]};
                *(LAS u32x2v*)(p + ((b1 + 16) ^ sw)) = (u32x2v){ktp[e][2], ktp[e][3]};
            }
#pragma unroll
            for (int e = 0; e < 8; ++e) { float t = nvp[e]; t += __shfl_xor(t, 16); t += __shfl_xor(t, 32); if (F.lane < 16) sNV[F.wave * 128 + cg * 8 + e] = t; }
        }
    }
    stage_vt(M.MV, row0, h * 128, F.lds + P2_VT, tid);
    __syncthreads();
    {
        const int r32 = F.lane & 31, hi = F.lane >> 5, mb = F.wave & 3, nb0 = 2 * (F.wave >> 2);
        f32x16 acc0 = f32x16{}, acc1 = f32x16{};
        const LAS unsigned char* pa = F.lds + P2_VT + (32 * mb + r32) * (KT_PITCH * 2);
        const LAS unsigned char* pb0 = F.lds + P2_KT + (32 * nb0 + r32) * (KT_PITCH * 2);
        const LAS unsigned char* pb1 = pb0 + 32 * (KT_PITCH * 2);
        const int swa = ((4 * mb + (r32 >> 3)) & 15) << 4, swb0 = ((4 * nb0 + (r32 >> 3)) & 15) << 4, swb1 = ((4 * nb0 + 4 + (r32 >> 3)) & 15) << 4;
#pragma unroll 4
        for (int ks = 0; ks < 16; ++ks) {
            const int o = ks * 32 + hi * 16;
            const bf16x8 av = *(const LAS bf16x8*)(pa + (o ^ swa)), b0 = *(const LAS bf16x8*)(pb0 + (o ^ swb0)), b1 = *(const LAS bf16x8*)(pb1 + (o ^ swb1));
            acc0 = __builtin_amdgcn_mfma_f32_32x32x16_bf16(av, b0, acc0, 0, 0, 0);
            acc1 = __builtin_amdgcn_mfma_f32_32x32x16_bf16(av, b1, acc1, 0, 0, 0);
        }
        float* Gu = M.G + (size_t)u * 16384;
#pragma unroll
        for (int rg2 = 0; rg2 < 16; ++rg2) { const int dv = 32 * mb + crow(rg2, hi);
            Gu[dv * 128 + 32 * nb0 + r32] = acc0[rg2]; Gu[dv * 128 + 32 * nb0 + 32 + r32] = acc1[rg2]; }
    }
    if (tid < 128) { float s = 0.f;
#pragma unroll
        for (int w = 0; w < 8; ++w) s += sNV[w * 128 + tid];
        M.NV[(size_t)u * 128 + tid] = s; }
    __syncthreads();
}

__device__ __forceinline__ void mlstm_scan_slice(const Frame& F, const MlstmBufs& M, int sidx) {
    const int bh = sidx >> 3, sl = sidx & 7, tid = F.tid;
    const int dv = 16 * sl + (tid >> 5), dk = (tid & 31) * 4;
    f32x4v g[16]; float dc[16], nv[16];
    const bool nrow = sl == 0 && tid < 128;
#pragma unroll
    for (int c = 0; c < 16; ++c) { g[c] = *(const f32x4v*)(M.G + (size_t)(bh * 16 + c) * 16384 + dv * 128 + dk); dc[c] = M.DC[bh * 16 + c];
        nv[c] = M.NV[(size_t)(bh * 16 + c) * 128 + (tid & 127)]; }
    f32x4v C = {0.f, 0.f, 0.f, 0.f};
#pragma unroll
    for (int c = 0; c < 16; ++c) {
        const int u = bh * 16 + c;
        *(uint2*)(M.Cst + (size_t)u * 16384 + dv * 128 + dk) = make_uint2(cvtpk(C[0], C[1]), cvtpk(C[2], C[3]));
        C = C * dc[c] + g[c];
    }
    if (nrow) {
        float n = 0.f;
#pragma unroll
        for (int c = 0; c < 16; ++c) { const int u = bh * 16 + c; M.NST[(size_t)u * 128 + tid] = n; n = n * dc[c] + nv[c]; }
    }
}

__device__ __forceinline__ void mlstm_p4_unit(const Frame& F, const MlstmBufs& M, int u) {
    const int b = u >> 6, h = (u >> 4) & 3, c = u & 15, tid = F.tid;
    const size_t row0 = (size_t)b * SEQ + c * ML;
    LAS float* sA = (LAS float*)(F.lds + P4_SC); LAS float* sB = sA + 256; LAS float* sN = sA + 512; LAS float* sH = sA + 640;
    if (tid < 256) { const float2 ab = *(const float2*)(M.AB + ((row0 + tid) * 4 + h) * 2); sA[tid] = ab.x; sB[tid] = ab.y; }
    else { int tq = tid; asm volatile("" : "+v"(tq));
        if (tq < 384) sN[tq - 256] = M.NST[(size_t)u * 128 + tq - 256];
        else sH[tq - 384] = M.hw[h * 128 + tq - 384]; }
#pragma unroll
    for (int i = 0; i < 8; ++i) { const int idx = tid + 512 * i, row = idx >> 4, seg = idx & 15;
        const v4u v = *(const v4u*)(M.MKc + (row0 + row) * 512 + h * 128 + seg * 8);
        *(LAS v4u*)(F.lds + P4_K + row * (KR_PITCH * 2) + seg * 16) = v; }
    stage_vt(M.MV, row0, h * 128, F.lds + P4_VT, tid);
    __syncthreads();
    const int w = F.wave < 4 ? F.wave : 11 - F.wave, r32 = F.lane & 31, hi = F.lane >> 5;
    const size_t trow = row0 + 32 * w + r32;
    bf16x8 qr[8];
#pragma unroll
    for (int ks = 0; ks < 8; ++ks) qr[ks] = *(const bf16x8*)(M.MQc + trow * 512 + h * 128 + 16 * ks + 8 * hi);
    const float Aq = sA[32 * w + r32], at = __builtin_amdgcn_exp2f(Aq);
    f32x16 o[4];
    const bf16_t* Cu = M.Cst + (size_t)u * 16384;
#pragma unroll
    for (int mb = 0; mb < 4; ++mb) {
        o[mb] = f32x16{};
#pragma unroll
        for (int ks = 0; ks < 8; ++ks) { const bf16x8 cf = *(const bf16x8*)(Cu + (32 * mb + r32) * 128 + 16 * ks + 8 * hi);
            o[mb] = __builtin_amdgcn_mfma_f32_32x32x16_bf16(cf, qr[ks], o[mb], 0, 0, 0); }
#pragma unroll
        for (int r = 0; r < 16; ++r) o[mb][r] *= at;
    }
    float den = 0.f;
#pragma unroll
    for (int ks = 0; ks < 8; ++ks) { const f32x4v n0 = *(const LAS f32x4v*)(sN + 16 * ks + 8 * hi), n1 = *(const LAS f32x4v*)(sN + 16 * ks + 8 * hi + 4);
#pragma unroll
        for (int j = 0; j < 4; ++j) { den += n0[j] * bf2f((unsigned short)qr[ks][j]); den += n1[j] * bf2f((unsigned short)qr[ks][4 + j]); } }
    den *= at;
    for (int kb = 0; kb <= w; ++kb) {
        f32x16 st = f32x16{};
        const LAS unsigned char* kp = F.lds + P4_K + (32 * kb + r32) * (KR_PITCH * 2) + hi * 16;
#pragma unroll
        for (int ks = 0; ks < 8; ++ks) { const bf16x8 kf = *(const LAS bf16x8*)(kp + ks * 32); st = __builtin_amdgcn_mfma_f32_32x32x16_bf16(kf, qr[ks], st, 0, 0, 0); }
        const bool diag = (kb == w);
#pragma unroll
        for (int g4 = 0; g4 < 4; ++g4) { const f32x4v bk = *(const LAS f32x4v*)(sB + 32 * kb + 8 * g4 + 4 * hi);
#pragma unroll
            for (int e = 0; e < 4; ++e) { const int r = 4 * g4 + e; float p = st[r] * __builtin_amdgcn_exp2f(Aq - bk[e]);
                if (diag && (8 * g4 + 4 * hi + e) > r32) p = 0.f;
                st[r] = p; den += p; } }
        bf16x8 pf[2];
#pragma unroll
        for (int s2 = 0; s2 < 2; ++s2) { v4u t; t.x = cvtpk(st[8 * s2], st[8 * s2 + 1]); t.y = cvtpk(st[8 * s2 + 2], st[8 * s2 + 3]); t.z = cvtpk(st[8 * s2 + 4], st[8 * s2 + 5]); t.w = cvtpk(st[8 * s2 + 6], st[8 * s2 + 7]);
            pf[s2] = __builtin_bit_cast(bf16x8, t); }
#pragma unroll
        for (int mb = 0; mb < 4; ++mb)
#pragma unroll
            for (int s2 = 0; s2 < 2; ++s2) { const bf16x8 vf = *(const LAS bf16x8*)(F.lds + P4_VT + (32 * mb + r32) * (KT_PITCH * 2) + (((32 * kb + 16 * s2 + 8 * hi) * 2) ^ (((4 * mb + (r32 >> 3)) & 15) << 4)));
                o[mb] = __builtin_amdgcn_mfma_f32_32x32x16_bf16(vf, pf[s2], o[mb], 0, 0, 0); }
    }
    { auto rr = __builtin_amdgcn_permlane32_swap(__float_as_uint(den), __float_as_uint(den), false, false); den = __uint_as_float(rr[0]) + __uint_as_float(rr[1]); }
    const float dinv = 1.f / fmaxf(fabsf(den), 1.f);
    float ss = 0.f;
#pragma unroll
    for (int mb = 0; mb < 4; ++mb)
#pragma unroll
        for (int r = 0; r < 16; ++r) { o[mb][r] *= dinv; ss += o[mb][r] * o[mb][r]; }
    { auto rr = __builtin_amdgcn_permlane32_swap(__float_as_uint(ss), __float_as_uint(ss), false, false); ss = __uint_as_float(rr[0]) + __uint_as_float(rr[1]); }
    const float rs = rsqrtf(ss * (1.f / 128.f) + EPS);
    {
        LAS unsigned char* stg = F.lds + P4_SC + 3072 + F.wave * 2560;
        const int srow = F.lane >> 2, sseg = F.lane & 3;
        const size_t grow = (row0 + 32 * w + srow) * 512 + h * 128 + 8 * sseg;
        v4u moin[4][2];
#pragma unroll
        for (int mb = 0; mb < 4; ++mb)
#pragma unroll
            for (int p = 0; p < 2; ++p) moin[mb][p] = *(const v4u*)(M.MO + grow + (size_t)(16 * p) * 512 + 32 * mb);
#pragma unroll
        for (int mb = 0; mb < 4; ++mb) {
#pragma unroll
            for (int p = 0; p < 2; ++p) *(LAS v4u*)(stg + (16 * p + srow) * 80 + sseg * 16) = moin[mb][p];
            asm volatile("s_waitcnt lgkmcnt(0)" ::: "memory");
            u32x2v yv[4];
#pragma unroll
            for (int g4 = 0; g4 < 4; ++g4) { const int dvl = 8 * g4 + 4 * hi, dv = 32 * mb + dvl;
                const u32x2v mo = *(const LAS u32x2v*)(stg + r32 * 80 + dvl * 2);
                const f32x4v hw = *(const LAS f32x4v*)(sH + dv);
                const float y0 = o[mb][4 * g4] * rs * hw[0] * bflo(mo.x), y1 = o[mb][4 * g4 + 1] * rs * hw[1] * bfhi(mo.x);
                const float y2 = o[mb][4 * g4 + 2] * rs * hw[2] * bflo(mo.y), y3 = o[mb][4 * g4 + 3] * rs * hw[3] * bfhi(mo.y);
                yv[g4] = (u32x2v){cvtpk(y0, y1), cvtpk(y2, y3)}; }
            asm volatile("s_waitcnt lgkmcnt(0)" ::: "memory");
#pragma unroll
            for (int g4 = 0; g4 < 4; ++g4) *(LAS u32x2v*)(stg + r32 * 80 + (8 * g4 + 4 * hi) * 2) = yv[g4];
            asm volatile("s_waitcnt lgkmcnt(0)" ::: "memory");
#pragma unroll
            for (int p = 0; p < 2; ++p) { const v4u t = *(const LAS v4u*)(stg + (16 * p + srow) * 80 + sseg * 16);
                *(v4u*)(M.Ym + grow + (size_t)(16 * p) * 512 + 32 * mb) = t; }
            asm volatile("s_waitcnt lgkmcnt(0)" ::: "memory");
        }
    }
    __syncthreads();
}
#ifndef REPMASK
#define REPMASK 0
#endif
__global__ void __launch_bounds__(NWAVES * 64, 2) mega(MArgs a) {
    extern __shared__ __attribute__((aligned(16))) unsigned char lds_raw[];
    Frame F;
    F.lds = (LAS unsigned char*)lds_raw;
    volatile LAS unsigned* MISC = (volatile LAS unsigned*)(F.lds + MISC_OFF);
    F.tid = threadIdx.x; F.lane = F.tid & 63; F.wave = __builtin_amdgcn_readfirstlane(F.tid >> 6);
    F.G = gridDim.x; { const int bx = blockIdx.x; F.vcu = (F.G % 8 == 0) ? (bx % 8) * (F.G / 8) + bx / 8 : bx; }
    unsigned char* ws = a.ws;
    int* ctl = (int*)(ws + WS_CTL * MiB);
    if (F.tid < 256) ((LAS unsigned*)(F.lds + MISC_OFF))[F.tid] = 0u;
    __syncthreads();
    XcdBarrier bar = xcd_barrier_post((unsigned*)(ctl + CW_BAR) + a.bar_region * XCD_BAR_WORDS, MISC + 8);
    const int lo = a.ph_lo, hi = a.ph_hi;
#define IN(k) (lo <= (k) && (k) < hi)
#define BOTH(k) (IN(k) && IN((k) + 1))
    if (IN(0)) _Pragma("unroll") for (int rep_ = 0; rep_ <= ((REPMASK >> 0) & 1); ++rep_) { p0_prologue(F, a); if (BOTH(0) || rep_ < ((REPMASK >> 0) & 1)) xcd_barrier(bar); }
    if (IN(1)) _Pragma("unroll") for (int rep_ = 0; rep_ <= ((REPMASK >> 1) & 1); ++rep_) {
        pg8::Gemm g{(const bf16_t*)(ws + WS_XN * MiB), (const bf16_t*)(ws + WS_WIN * MiB), T_TOK, TIN, 1024};
        pg8::StaticOrder S; S.init(T_TOK, TIN, F.G, (int)blockIdx.x);
        pg8::EpiProj E{ws + WS_Q * MiB, (const float2*)(ws + WS_ROPE * MiB), (float*)(ws + WS_KMP * MiB)};
        const int grp = (blockIdx.x >> 3) & 7;
        const int trig = grp == 0 ? 0 : (grp == 7 ? 1 << 30 : (grp * 3 + 1) / 2);
        if (grp == 0) p0_fp8_weights(F, a);
        HookOrder SH; SH.init(T_TOK, TIN, F.G, (int)blockIdx.x); SH.F = &F; SH.a = &a; SH.trigger = trig; SH.count = 0;
        pg8::gemm_phase<pg8::EpiProj, HookOrder, true, true>(F.lds, g, SH, E);
        if (grp == 7 || SH.count < trig) p0_fp8_weights(F, a);
        if (BOTH(1) || rep_ < ((REPMASK >> 1) & 1)) xcd_barrier(bar);
    }
    MlstmBufs MB{(const bf16_t*)(ws + WS_MQ * MiB), (const bf16_t*)(ws + WS_MK * MiB), (const bf16_t*)(ws + WS_MV * MiB), (const bf16_t*)(ws + WS_MO * MiB),
                 (const float*)(ws + WS_GATES * MiB), a.in[3], a.in[4], a.in[6], (bf16_t*)(ws + WS_MQC * MiB), (bf16_t*)(ws + WS_MKC * MiB),
                 (float*)(ws + WS_G * MiB), (bf16_t*)(ws + WS_CST * MiB), (float*)(ws + WS_AB * MiB), (float*)(ws + WS_NV * MiB), (float*)(ws + WS_NST * MiB), (float*)(ws + WS_DC * MiB),
                 (bf16_t*)(ws + WS_YM * MiB)};
    if (IN(2)) _Pragma("unroll") for (int rep_ = 0; rep_ <= ((REPMASK >> 2) & 1); ++rep_) {
        for (int u = F.vcu; u < MUNITS; u += F.G) mlstm_p2_unit(F, MB, u);
        if (BOTH(2) || rep_ < ((REPMASK >> 2) & 1)) xcd_barrier(bar);
    }
    if (IN(3)) _Pragma("unroll") for (int rep_ = 0; rep_ <= ((REPMASK >> 3) & 1); ++rep_) {
        for (int sidx = F.vcu; sidx < 256; sidx += F.G) mlstm_scan_slice(F, MB, sidx);
        if (a.flags & 1) {
            v4u* ya = (v4u*)(ws + WS_YA * MiB);
            for (size_t i = (size_t)blockIdx.x * 512 + F.tid; i < (size_t)T_TOK * 512 * 2 / 16; i += (size_t)F.G * 512) ya[i] = (v4u){0u, 0u, 0u, 0u};
        }
        if (!(a.flags & 1)) {
            __syncthreads();
            const attn_body::AttnTensors AT{(const attn_body::bf16*)(ws + WS_Q * MiB), (const attn_body::bf16*)(ws + WS_K * MiB), (const attn_body::bf16*)(ws + WS_V * MiB), (attn_body::bf16*)(ws + WS_YA * MiB), (const float*)(ws + WS_KMP * MiB)};
            const attn_body::StaticOrder SA((int)F.G, (int)blockIdx.x, (a.flags >> 2) & 1);
            attn_body::attn_phase<attn_body::StaticOrder>((char*)lds_raw, AT, SA);
        }
        if (BOTH(3) || rep_ < ((REPMASK >> 3) & 1)) xcd_barrier(bar);
    }
    if (IN(4)) _Pragma("unroll") for (int rep_ = 0; rep_ <= ((REPMASK >> 4) & 1); ++rep_) {
        for (int u = F.vcu; u < MUNITS; u += F.G) mlstm_p4_unit(F, MB, u);
        if (BOTH(4) || rep_ < ((REPMASK >> 4) & 1)) xcd_barrier(bar);
    }
    if (IN(5)) _Pragma("unroll") for (int rep_ = 0; rep_ <= ((REPMASK >> 5) & 1); ++rep_) {
        bf16_t* merged = (bf16_t*)(ws + WS_MERGED * MiB);
        { pg8::Gemm g{(const bf16_t*)(ws + WS_YM * MiB), (const bf16_t*)(ws + WS_WB * MiB) + (size_t)1024 * 512, T_TOK, 1024, 512};
          pg8::StaticOrder S; S.init(T_TOK, 1024, F.G, (int)blockIdx.x);
          pg8::EpiBranch<false> E{(const unsigned char*)(ws + WS_GM * MiB), merged};
          pg8::gemm_phase<pg8::EpiBranch<false>, pg8::StaticOrder, true, true>(F.lds, g, S, E); }
        { pg8::Gemm g{(const bf16_t*)(ws + WS_YA * MiB), (const bf16_t*)(ws + WS_WB * MiB), T_TOK, 1024, 512};
          pg8::StaticOrder S; S.init(T_TOK, 1024, F.G, (int)blockIdx.x);
          pg8::EpiBranch<true> E{(const unsigned char*)(ws + WS_GA * MiB), merged};
          pg8::gemm_phase<pg8::EpiBranch<true>, pg8::StaticOrder, true, true>(F.lds, g, S, E); }
        if (BOTH(5) || rep_ < ((REPMASK >> 5) & 1)) xcd_barrier(bar);
    }
    if (IN(6)) _Pragma("unroll") for (int rep_ = 0; rep_ <= ((REPMASK >> 6) & 1); ++rep_) {
        pg8::Gemm g{(const bf16_t*)(ws + WS_MERGED * MiB), (const bf16_t*)(ws + WS_WO * MiB), T_TOK, 1024, 1024};
        pg8::StaticOrder S; S.init(T_TOK, 1024, F.G, (int)blockIdx.x);
        pg8::EpiOutRes E{a.in[0], (bf16_t*)(ws + WS_H * MiB)};
        pg8::gemm_phase<pg8::EpiOutRes, pg8::StaticOrder, true, true>(F.lds, g, S, E);
        if (BOTH(6) || rep_ < ((REPMASK >> 6) & 1)) xcd_barrier(bar);
    }
    volatile LAS int* tp = (volatile LAS int*)(F.lds + MISC_OFF) + TP_OFF;
    int* cnt = ctl + CW_CNT;
    int* asg_e = (int*)(ws + WS_ASGE * MiB); int* asg_pos = (int*)(ws + WS_ASGP * MiB); float* asg_g = (float*)(ws + WS_ASGG * MiB); int* list = (int*)(ws + WS_LIST * MiB);
    if (IN(7)) _Pragma("unroll") for (int rep_ = 0; rep_ <= ((REPMASK >> 7) & 1); ++rep_) {
        LAS bf16_t* whi = (LAS bf16_t*)F.lds; LAS bf16_t* wlo = whi + 32 * WR_PITCH; LAS float* lgs = (LAS float*)(F.lds + 4 * 32 * WR_PITCH) + F.wave * 512;
        __syncthreads();
        LAS int* hist = (LAS int*)(F.lds + MISC_OFF) + 72; LAS int* hbase = hist + 32;
        for (int it = 0; it * F.G * NWAVES < T_TOK / 16; ++it) { const int bt = (it * F.G + F.vcu) * NWAVES + F.wave; const bool valid = bt < T_TOK / 16;
            Frame F7 = F; asm volatile("" : "+v"(F7.tid), "+v"(F7.lane));
            HRows R; if (valid) hrows_load(R, (const bf16_t*)(ws + WS_H * MiB), bt * 16, F7.lane);
            if (it == 0) { stage_wsplit_dense32(a.in[10], a.in[9], whi, wlo, F7.tid); __syncthreads(); }
            router_round_regs(F7, bt, valid, R, a.in[9], whi, wlo, lgs, hist, hbase, a.in[11], (unsigned char*)(ws + WS_XN * MiB), cnt, asg_e, asg_pos, asg_g, list); }
        if (BOTH(7) || rep_ < ((REPMASK >> 7) & 1)) xcd_barrier(bar);
        if (rep_ < ((REPMASK >> 7) & 1)) { if (blockIdx.x == 0 && F.tid < 32) cnt[F.tid * CNT_STRIDE] = 0; xcd_barrier(bar); }
    }
    if (IN(8)) _Pragma("unroll") for (int rep_ = 0; rep_ <= ((REPMASK >> 8) & 1); ++rep_) {
        moe_prefix(F, cnt, tp);
        pg8::Gemm g{(const bf16_t*)(ws + WS_XN * MiB), (const bf16_t*)(ws + WS_W1 * MiB), 0, 2048, MOE1_FP8 ? 512 : 1024};
        pg8::GroupedOrder S; S.init(tp[32], 8, F.G, (int)blockIdx.x, tp, list, cnt);
        pg8::EpiMlp1 E{a.in[13], (bf16_t*)(ws + WS_ACT * MiB)};
        const int nu = moe_build_tables(F, S, 1, list);
        if (nu >= 0) { pg8::TableOrder ST{(const volatile LAS int*)(F.lds + pg8::UT_OFF), (const volatile LAS int*)(F.lds + pg8::UT_TOK_OFF), nu};
            pg8::gemm_phase<pg8::EpiMlp1, pg8::TableOrder, true, true, true, MOE1_FP8>(F.lds, g, ST, E); }

        if (BOTH(8) || rep_ < ((REPMASK >> 8) & 1)) xcd_barrier(bar);
    }
    if (IN(9)) _Pragma("unroll") for (int rep_ = 0; rep_ <= ((REPMASK >> 9) & 1); ++rep_) {
        moe_prefix(F, cnt, tp);
        pg8::Gemm g{(const bf16_t*)(ws + WS_ACT * MiB), (const bf16_t*)(ws + WS_W2 * MiB), 0, 1024, MOE2_FP8 ? 512 : 1024};
        pg8::GroupedOrder S; S.init(tp[32], 4, F.G, (int)blockIdx.x, tp, MOE2_FP8 ? nullptr : list, cnt);
        pg8::EpiMlp2 E{a.in[15], (bf16_t*)(ws + WS_YROWS * MiB), (const volatile LAS int*)(F.lds + pg8::UT_TOK_OFF)};
        const int nu = moe_build_tables(F, S, 2, list);
        if (nu >= 0) { pg8::TableOrder ST{(const volatile LAS int*)(F.lds + pg8::UT_OFF), nullptr, nu};
            pg8::gemm_phase<pg8::EpiMlp2, pg8::TableOrder, true, true, MOE2_FP8, MOE2_FP8>(F.lds, g, ST, E); }

        if (BOTH(9) || rep_ < ((REPMASK >> 9) & 1)) xcd_barrier(bar);
    }
    if (IN(10)) _Pragma("unroll") for (int rep_ = 0; rep_ <= ((REPMASK >> 10) & 1); ++rep_) {
        moe_prefix(F, cnt, tp);
        float dscale = 1.f;
        if (a.flags & 2) { const float* dg = (const float*)(ctl + CW_DIAG); dscale = 1.f + sqrtf(dg[0] / fmaxf(dg[1], 1e-30f)) + sqrtf(dg[2] / fmaxf(dg[3], 1e-30f)); }
        const int gw = F.vcu * NWAVES + F.wave, NGW = F.G * NWAVES;
        f32x4v wfv[4];
#pragma unroll
        for (int q = 0; q < 4; ++q) wfv[q] = *(const f32x4v*)(a.in[16] + 256 * q + 4 * F.lane);
        for (int row = gw; row < T_TOK; row += NGW)
            if (pg8::Y_FP8) final_row_f8(row, F.lane, (const bf16_t*)(ws + WS_H * MiB), (const unsigned char*)(ws + WS_YROWS * MiB), asg_g, wfv, a.out, dscale, (LAS float*)F.lds + F.wave * 1024);
            else final_row(row, F.lane, (const bf16_t*)(ws + WS_H * MiB), (const bf16_t*)(ws + WS_YROWS * MiB), asg_g, a.in[16], a.out, dscale);
        if (rep_ < ((REPMASK >> 10) & 1)) xcd_barrier(bar);
    }
#undef IN
#undef BOTH
}
extern "C" void kernel_launch(void* const* d_in, const int* in_sizes, int n_in, void* d_out, int out_size, void* d_ws, size_t ws_size, hipStream_t stream) {
    static int grid = 0;
    if (grid == 0) {
        if (n_in != 17 || ws_size < WS_END * MiB || in_sizes[0] != T_TOK * DM || out_size != T_TOK * DM) { fprintf(stderr, "kernel_launch: unexpected n_in %d / ws %zu\n", n_in, ws_size); grid = -1; return; }
        int dev = 0, cus = 0, per_cu = 0;
        if (hipGetDevice(&dev) != hipSuccess || hipDeviceGetAttribute(&cus, hipDeviceAttributeMultiprocessorCount, dev) != hipSuccess) { grid = -1; return; }
        if (hipFuncSetAttribute((const void*)mega, hipFuncAttributeMaxDynamicSharedMemorySize, LDS_BYTES) != hipSuccess) { fprintf(stderr, "kernel_launch: hipFuncSetAttribute failed\n"); grid = -1; return; }
        if (hipOccupancyMaxActiveBlocksPerMultiprocessor(&per_cu, (const void*)mega, NWAVES * 64, LDS_BYTES) != hipSuccess || per_cu < 1) { fprintf(stderr, "kernel_launch: occupancy query says %d\n", per_cu); per_cu = 1; }
        (void)hipGetLastError();
        grid = cus;
        if (grid * pg8::UT_MAXU < (MAXROWS / 256) * 8) { fprintf(stderr, "kernel_launch: %d CUs: the per-workgroup MoE unit table (%d units) is sized for MI355X (256 CUs)\n", grid, pg8::UT_MAXU); grid = -1; return; }
    }
    if (grid < 0) return;
    (void)hipMemsetAsync(d_ws, 0, 65536, stream);
    MArgs ma{};
    for (int i = 0; i < 17; ++i) ma.in[i] = (const float*)d_in[i];
    ma.out = (float*)d_out; ma.ws = (unsigned char*)d_ws; ma.ph_lo = 0; ma.ph_hi = 11; ma.bar_region = 0; ma.flags = 0;
#ifdef PROBE_FLAGS
    ma.flags = PROBE_FLAGS;
#endif
    void* args[] = {&ma};
    hipError_t e = hipLaunchCooperativeKernel((const void*)mega, dim3(grid), dim3(NWAVES * 64), args, LDS_BYTES, stream);
    if (e != hipSuccess) fprintf(stderr, "cooperative launch failed: %s (grid %d)\n", hipGetErrorString(e), grid);
}
```

```cpp
#include <hip/hip_runtime.h>
#include <stdint.h>
#include <math.h>
#include <cstdio>

typedef unsigned short bf16_t;
typedef short bf16x8 __attribute__((ext_vector_type(8)));
typedef float f32x16 __attribute__((ext_vector_type(16)));

constexpr int T_TOK = 32768, DM = 1024, SEQ = 4096, NB = 8;
constexpr int IN_COLS = 5640;
constexpr float EPS = 1e-6f;
constexpr float C2 = 0.125f * 1.4426950408889634f;
constexpr size_t MiB = 1u << 20;
constexpr size_t WS_CTL = 0, WS_ROPE = 8, WS_KMEAN = 9, WS_ASGE = 10, WS_ASGP = 11, WS_ASGG = 12, WS_ROWTOK = 13, WS_LIST = 14, WS_GATES = 18, WS_KMP = 19;
constexpr size_t WS_WIN = 20, WS_WB = 32, WS_WO = 34, WS_W1 = 36, WS_W2 = 164, WS_H = 228, WS_XN = 356;
constexpr size_t WS_Q = 420, WS_K = 452, WS_V = 484, WS_MQ = 516, WS_MK = 548, WS_MV = 580, WS_MO = 612, WS_GA = 644, WS_GM = 708;
constexpr size_t WS_QRAW = 772, WS_KRAW = 836, WS_HRAW = 772, WS_MERGED = 836, WS_YA = 900, WS_YM = 932;
constexpr size_t WS_MQC = 772, WS_MKC = 804, WS_G = 356, WS_CST = 388, WS_AB = 404, WS_NV = 405, WS_NST = 406, WS_DC = 407;
constexpr size_t WS_ACT = 420, WS_YROWS = 692, WS_END = 964;
constexpr int MAXROWS = 131072 + 32 * 256;
constexpr int CW_CNT = 0, CW_NROWS = 64, CW_PSTART = 128, CW_TILEE = 256, CW_DIAG = 1024;
constexpr size_t WS_YAREF = 964;

__device__ __forceinline__ unsigned short f2bf(float f) { unsigned u = __float_as_uint(f); u += 0x7fffu + ((u >> 16) & 1u); return (unsigned short)(u >> 16); }
__device__ __forceinline__ float bf2f(unsigned short b) { return __uint_as_float(((unsigned)b) << 16); }
__device__ __forceinline__ float wave_sum(float v) {
#pragma unroll
    for (int o = 32; o > 0; o >>= 1) v += __shfl_xor(v, o);
    return v; }
__device__ __forceinline__ float wave_max(float v) {
#pragma unroll
    for (int o = 32; o > 0; o >>= 1) v = fmaxf(v, __shfl_xor(v, o));
    return v; }
__device__ __forceinline__ float sigm(float x) { return 1.f / (1.f + __expf(-x)); }

__device__ __forceinline__ int crow(int r, int hi) { return (r & 3) + 8 * (r >> 2) + 4 * hi; }
namespace pg8 {
#define PG8_LAS __attribute__((address_space(3)))
typedef unsigned short bf16_t;
typedef short bf16x8 __attribute__((ext_vector_type(8)));
typedef float f32x4 __attribute__((ext_vector_type(4)));
typedef unsigned u32x4 __attribute__((ext_vector_type(4)));
__device__ __forceinline__ void st16_wt(void* p, u32x4 v) { asm volatile("global_store_dwordx4 %0, %1, off sc1\n\ts_nop 1" :: "v"(p), "v"(v)); }
constexpr int BM = 256, BK = 64, HALF = 128, HTB = HALF * BK * 2  , STAGE_BYTES = 8 * HTB, NXCD = 8, WGM = 8;

__host__ __device__ __forceinline__ int lds_byte(int r, int c) { const int st = (r >> 4) * 2 + (c >> 5), rr = r & 15, cc = c & 31, ob = rr * 64 + cc * 2; return st * 1024 + (ob ^ (((ob >> 9) & 1) << 5)); }
__host__ __device__ __forceinline__ void stage_rc(int b, int& R, int& C) { const int st = b / 1024, sb = b % 1024, swz = sb ^ (((sb >> 9) & 1) << 5); R = (st >> 1) * 16 + swz / 64; C = (st & 1) * 32 + (swz % 64) / 2; }
__host__ __device__ __forceinline__ int perm32(int rho) { const int n = rho >> 4, i = rho & 15; return 8 * (i >> 2) + 4 * n + (i & 3); }

struct Unit { int pm, pn, e, pnl, rtl, ui; };
struct Gemm { const bf16_t* A; const bf16_t* Bt; int M, N, K; };

struct StaticOrder {
    int nM, nN, nwg, G, c;
    __host__ __device__ void init(int M, int N, int G_, int c_) { nM = M / BM; nN = N / BM; nwg = nM * nN; G = G_; c = c_; }
    __host__ __device__ bool next(int i, Unit& u) const {
        const long L = (long)i * G + c; if (L >= nwg) return false;
        int wgid = (int)L; { const int q = nwg / NXCD, r = nwg % NXCD, xcd = wgid % NXCD, off = wgid / NXCD; wgid = (xcd < r ? xcd * (q + 1) : r * (q + 1) + (xcd - r) * q) + off; }
        const int nig = WGM * nN, gid = wgid / nig, fm = gid * WGM, gsz = (nM - fm) < WGM ? (nM - fm) : WGM;
        u.pm = fm + ((wgid % nig) % gsz); u.pn = (wgid % nig) / gsz; return true;
    }
    __device__ __forceinline__ void a_ready(const Unit&) const {}
    __device__ __forceinline__ void done(const Unit&) const {}
};

__device__ __forceinline__ unsigned cvt_pk_bf16(float lo, float hi) { typedef float f2v_ __attribute__((ext_vector_type(2))); typedef __bf16 b2v_ __attribute__((ext_vector_type(2)));
    const f2v_ v = {lo, hi}; return __builtin_bit_cast(unsigned, __builtin_convertvector(v, b2v_)); }
typedef float f32x2 __attribute__((ext_vector_type(2)));
template <class Epi, class Sched, bool ALIGN_EPI = false, bool SP2 = false, bool GATHER = false, bool FP8 = false>
__device__ __forceinline__ void gemm_phase(PG8_LAS unsigned char* lds, const Gemm g, const Sched& S, const Epi& E) {
    const int tid = threadIdx.x, wid = __builtin_amdgcn_readfirstlane(tid >> 6), lane = tid & 63, wr = wid >> 2, wc = wid & 3, fr = lane & 15, fq = lane >> 4;
    typedef int pg8_i32x4 __attribute__((ext_vector_type(4))); typedef int pg8_i32x8 __attribute__((ext_vector_type(8)));
    const int K = g.K, nt = K / BK;
    unsigned voffA[2], voffB[2];
#pragma unroll
    for (int i = 0; i < 2; ++i) { int R, C; stage_rc(tid * 16 + i * 8192, R, C); const int Rb = Epi::PERM ? ((R & ~31) + perm32(R & 31)) : R;
        voffA[i] = (unsigned)(R * K + C) * 2u; voffB[i] = (unsigned)(Rb * K + C) * 2u; }
    static_assert(!GATHER || SP2, "gather needs the SP2 loop");
    unsigned gAc[2][2] = {{0u, 0u}, {0u, 0u}}, gAn[2][2] = {{0u, 0u}, {0u, 0u}};
    const size_t kstep = (size_t)(BK * 2);
    const size_t hstep = (size_t)HALF * K * 2;
    const size_t qstep = (size_t)64 * K * 2;
    const size_t tstep = 2 * hstep;
    const unsigned ldsw = (unsigned)wid * 1024u;
    const int aoff = lds_byte(wr * 64 + fr, fq * 8), boff = lds_byte(wc * 32 + fr, fq * 8);
#define PG8_SA(b, h) (((b) * 2 + (h)) * HTB)
#define PG8_SB(b, h) ((4 + (b) * 2 + (h)) * HTB)
#define PG8_STAGE(bufoff, gbase, voff) do { _Pragma("unroll") for (int _i = 0; _i < 2; ++_i) \
        __builtin_amdgcn_global_load_lds((const unsigned*)((const char*)(gbase) + (voff)[_i]), (PG8_LAS unsigned*)(lds + (bufoff) + ldsw + _i * 8192), 16, 0, 0); } while (0)
#define PG8_STAGE1(bufoff, gbase, voff0) do { _Pragma("unroll") for (int _i = 0; _i < 2; ++_i) \
        __builtin_amdgcn_global_load_lds((const unsigned*)((const char*)(gbase) + (size_t)_i * qstep + (voff0)), (PG8_LAS unsigned*)(lds + (bufoff) + ldsw + _i * 8192), 16, 0, 0); } while (0)
#define PG8_STAGEA(bufoff, gbase, h, gsel) do { if constexpr (GATHER) { PG8_STAGE(bufoff, gbase, gsel[h]); } else { PG8_STAGE1(bufoff, (gbase) + (h) * hstep, voffA[0]); } } while (0)
#define PG8_LD16(off) (*(const PG8_LAS pg8_i32x4*)(lds + (off)))
#define PG8_LDA(dst, b, h) do { _Pragma("unroll") for (int m = 0; m < 4; ++m) { if constexpr (FP8) { dst##8[m] = __builtin_shufflevector(PG8_LD16(PG8_SA(b, h) + aoff + m * 2048), PG8_LD16(PG8_SA(b, h) + aoff + m * 2048 + 1024), 0, 1, 2, 3, 4, 5, 6, 7); } \
        else { _Pragma("unroll") for (int k = 0; k < 2; ++k) dst[m][k] = *(const PG8_LAS bf16x8*)(lds + PG8_SA(b, h) + aoff + m * 2048 + k * 1024); } } } while (0)
#define PG8_LDB(dst, b, h) do { _Pragma("unroll") for (int n = 0; n < 2; ++n) { if constexpr (FP8) { dst##8[n] = __builtin_shufflevector(PG8_LD16(PG8_SB(b, h) + boff + n * 2048), PG8_LD16(PG8_SB(b, h) + boff + n * 2048 + 1024), 0, 1, 2, 3, 4, 5, 6, 7); } \
        else { _Pragma("unroll") for (int k = 0; k < 2; ++k) dst[n][k] = *(const PG8_LAS bf16x8*)(lds + PG8_SB(b, h) + boff + n * 2048 + k * 1024); } } } while (0)
#define PG8_CAT(x0, x1) __builtin_shufflevector(__builtin_bit_cast(pg8_i32x4, x0), __builtin_bit_cast(pg8_i32x4, x1), 0, 1, 2, 3, 4, 5, 6, 7)
#define PG8_MMA(ai, bj, At, Bt) do { __builtin_amdgcn_s_setprio(1); if constexpr (FP8) { _Pragma("unroll") for (int m = 0; m < 4; ++m) _Pragma("unroll") for (int n = 0; n < 2; ++n) \
        acc[ai][bj][m][n] = __builtin_amdgcn_mfma_scale_f32_16x16x128_f8f6f4(Bt##8[n], At##8[m], acc[ai][bj][m][n], 0, 0, 0, 0x7a7a7a7a, 0, 0x7f7f7f7f); } else { \
        _Pragma("unroll") for (int m = 0; m < 4; ++m) _Pragma("unroll") for (int n = 0; n < 2; ++n) _Pragma("unroll") for (int k = 0; k < 2; ++k) \
        acc[ai][bj][m][n] = __builtin_amdgcn_mfma_f32_16x16x32_bf16(Bt[n][k], At[m][k], acc[ai][bj][m][n], 0, 0, 0); } __builtin_amdgcn_s_setprio(0); } while (0)
#define PG8_WAIT_V(n) asm volatile("s_waitcnt vmcnt(" #n ")" ::: "memory")
#define PG8_WAIT_L(n) asm volatile("s_waitcnt lgkmcnt(" #n ")" ::: "memory")
#define PG8_BAR __builtin_amdgcn_s_barrier()
#define PG8_SCHED __builtin_amdgcn_sched_barrier(0)
    Unit cur, nxt; int ui = 0;
    if (!S.next(0, cur)) return;
    f32x4 acc[2][2][4][2];
#pragma unroll
    for (int a = 0; a < 2; ++a)
#pragma unroll
        for (int b = 0; b < 2; ++b)
#pragma unroll
            for (int m = 0; m < 4; ++m)
#pragma unroll
                for (int n = 0; n < 2; ++n) acc[a][b][m][n] = (f32x4){0.f, 0.f, 0.f, 0.f};
    bf16x8 At[4][2], B0[2][2], B1[2][2]; pg8_i32x8 At8[4], B08[2], B18[2];
    const char* cA = GATHER ? (const char*)g.A : (const char*)g.A + (size_t)cur.pm * tstep; const char* cB = (const char*)g.Bt + (size_t)cur.pn * tstep;
    if constexpr (GATHER) S.gather(cur, tid, K, gAc);
    S.a_ready(cur);
    if constexpr (SP2) {
        PG8_STAGE1(PG8_SB(0, 0), cB, voffB[0]); PG8_STAGE1(PG8_SB(0, 1), cB + hstep, voffB[0]); PG8_STAGEA(PG8_SA(0, 0), cA, 0, gAc); PG8_STAGEA(PG8_SA(0, 1), cA, 1, gAc);
        if (wr == 1) PG8_BAR;
        PG8_WAIT_V(2); PG8_BAR;
        PG8_STAGE1(PG8_SB(1, 0), cB + kstep, voffB[0]); PG8_STAGEA(PG8_SA(1, 0), cA + kstep, 0, gAc); PG8_STAGE1(PG8_SB(1, 1), cB + hstep + kstep, voffB[0]);
        PG8_WAIT_V(6); PG8_BAR;
    } else {
        PG8_STAGE1(PG8_SB(0, 0), cB, voffB[0]); PG8_STAGE(PG8_SA(0, 0), cA, voffA); PG8_STAGE1(PG8_SB(0, 1), cB + hstep, voffB[0]); PG8_STAGE(PG8_SA(0, 1), cA + hstep, voffA);
        if (wr == 1) PG8_BAR;
        PG8_WAIT_V(4); PG8_BAR;
        PG8_STAGE1(PG8_SB(1, 0), cB + kstep, voffB[0]); PG8_STAGE(PG8_SA(1, 0), cA + kstep, voffA); PG8_STAGE1(PG8_SB(1, 1), cB + hstep + kstep, voffB[0]);
        PG8_WAIT_V(6); PG8_BAR;
    }
    for (;;) {
        const bool has_next = S.next(ui + 1, nxt);
        if constexpr (GATHER) { if (has_next) S.gather(nxt, tid, K, gAn); else { gAn[0][0] = gAc[0][0]; gAn[0][1] = gAc[0][1]; gAn[1][0] = gAc[1][0]; gAn[1][1] = gAc[1][1]; } }
        const char* nA = GATHER ? (const char*)g.A : (has_next ? (const char*)g.A + (size_t)nxt.pm * tstep : cA); const char* nB = has_next ? (const char*)g.Bt + (size_t)nxt.pn * tstep : cB;
#pragma unroll 1
        for (int t = 0; t < nt; t += 2) {
            if constexpr (Epi::MIDK) { if (t == nt / 2) E.midk(acc, cur, wr, wc, fr, fq); }
            const bool last = (t == nt - 2);
            const char* a1 = cA + (size_t)(t + 1) * kstep;
            const char* a2 = last ? nA : cA + (size_t)(t + 2) * kstep; const char* b2 = last ? nB : cB + (size_t)(t + 2) * kstep;
            const char* a3 = a2 + kstep; const char* b3 = b2 + kstep;
            if (last && has_next) S.a_ready(nxt);
            if constexpr (SP2) {
            PG8_LDB(B0, 0, 0); PG8_LDB(B1, 0, 1); PG8_SCHED; PG8_LDA(At, 0, 0); PG8_STAGEA(PG8_SA(1, 1), a1, 1, gAc);
            if constexpr (GATHER) { if (last) { gAc[0][0] = gAn[0][0]; gAc[0][1] = gAn[0][1]; gAc[1][0] = gAn[1][0]; gAc[1][1] = gAn[1][1]; } }
            PG8_WAIT_V(8); PG8_WAIT_L(0); PG8_BAR; PG8_MMA(0, 0, At, B0); PG8_MMA(0, 1, At, B1); PG8_BAR; PG8_SCHED;
            PG8_LDA(At, 0, 1); PG8_STAGE1(PG8_SB(0, 0), b2, voffB[0]); PG8_STAGE1(PG8_SB(0, 1), b2 + hstep, voffB[0]); PG8_STAGEA(PG8_SA(0, 0), a2, 0, gAc);
            PG8_WAIT_V(8); PG8_WAIT_L(0); PG8_BAR; PG8_MMA(1, 0, At, B0); PG8_MMA(1, 1, At, B1); PG8_BAR; PG8_SCHED;
            PG8_LDB(B0, 1, 0); PG8_LDB(B1, 1, 1); PG8_SCHED; PG8_LDA(At, 1, 0); PG8_STAGEA(PG8_SA(0, 1), a2, 1, gAc);
            PG8_WAIT_V(8); PG8_WAIT_L(0); PG8_BAR; PG8_MMA(0, 0, At, B0); PG8_MMA(0, 1, At, B1); PG8_BAR; PG8_SCHED;
            PG8_LDA(At, 1, 1); PG8_STAGE1(PG8_SB(1, 0), b3, voffB[0]); PG8_STAGE1(PG8_SB(1, 1), b3 + hstep, voffB[0]); PG8_STAGEA(PG8_SA(1, 0), a3, 0, gAc);
            PG8_WAIT_V(8); PG8_WAIT_L(0); PG8_BAR; PG8_MMA(1, 0, At, B0); PG8_MMA(1, 1, At, B1); PG8_BAR; PG8_SCHED;
            } else {
            PG8_LDB(B0, 0, 0); PG8_SCHED; PG8_LDA(At, 0, 0); PG8_STAGE(PG8_SA(1, 1), a1 + hstep, voffA);
            PG8_WAIT_L(8); PG8_BAR; PG8_WAIT_L(0); PG8_MMA(0, 0, At, B0); PG8_BAR; PG8_SCHED;
            PG8_LDB(B1, 0, 1); PG8_STAGE1(PG8_SB(0, 0), b2, voffB[0]);
            PG8_BAR; PG8_WAIT_L(0); PG8_MMA(0, 1, At, B1); PG8_BAR;
            PG8_LDA(At, 0, 1); PG8_STAGE(PG8_SA(0, 0), a2, voffA);
            PG8_BAR; PG8_WAIT_L(0); PG8_MMA(1, 0, At, B0); PG8_BAR; PG8_SCHED;
            PG8_STAGE1(PG8_SB(0, 1), b2 + hstep, voffB[0]);
            PG8_WAIT_V(6); PG8_BAR; PG8_MMA(1, 1, At, B1); PG8_BAR;
            PG8_LDB(B0, 1, 0); PG8_SCHED; PG8_LDA(At, 1, 0); PG8_STAGE(PG8_SA(0, 1), a2 + hstep, voffA);
            PG8_WAIT_L(8); PG8_BAR; PG8_WAIT_L(0); PG8_MMA(0, 0, At, B0); PG8_BAR; PG8_SCHED;
            PG8_LDB(B1, 1, 1); PG8_STAGE1(PG8_SB(1, 0), b3, voffB[0]);
            PG8_BAR; PG8_WAIT_L(0); PG8_MMA(0, 1, At, B1); PG8_BAR;
            PG8_LDA(At, 1, 1); PG8_STAGE(PG8_SA(1, 0), a3, voffA);
            PG8_BAR; PG8_WAIT_L(0); PG8_MMA(1, 0, At, B0); PG8_BAR; PG8_SCHED;
            PG8_STAGE1(PG8_SB(1, 1), b3 + hstep, voffB[0]);
            PG8_WAIT_V(6); PG8_BAR; PG8_MMA(1, 1, At, B1); PG8_BAR;
            }
        }
        if constexpr (ALIGN_EPI) { if (wr == 0) PG8_BAR; }
        if constexpr (!Epi::AFTER_DRAIN) { E(acc, cur, wr, wc, fr, fq); S.done(cur); }
        if (!has_next) break;
#pragma unroll
        for (int a = 0; a < 2; ++a)
#pragma unroll
            for (int b = 0; b < 2; ++b)
#pragma unroll
                for (int m = 0; m < 4; ++m)
#pragma unroll
                    for (int n = 0; n < 2; ++n) acc[a][b][m][n] = (f32x4){0.f, 0.f, 0.f, 0.f};
        cur = nxt; cA = nA; cB = nB; ++ui;
        if constexpr (ALIGN_EPI) { if (wr == 1) PG8_BAR; }
    }
    PG8_WAIT_V(0);
    if constexpr (!ALIGN_EPI) { if (wr == 0) PG8_BAR; }
    PG8_BAR;
    if constexpr (Epi::AFTER_DRAIN) { E.fused(acc, cur, wr, wc, fr, fq, lds, wid, lane); S.done(cur); }
#undef PG8_SA
#undef PG8_SB
#undef PG8_STAGE
#undef PG8_STAGE1
#undef PG8_STAGEA
#undef PG8_LDA
#undef PG8_LDB
#undef PG8_MMA
#undef PG8_CAT
#undef PG8_WAIT_V
#undef PG8_WAIT_L
#undef PG8_BAR
#undef PG8_SCHED
}
}
#define GAS __attribute__((address_space(1)))
#define LAS __attribute__((address_space(3)))
typedef unsigned v4u __attribute__((ext_vector_type(4)));
typedef float f32x4 __attribute__((ext_vector_type(4)));
typedef short bf16x8 __attribute__((ext_vector_type(8)));
typedef GAS unsigned gu32;
typedef GAS unsigned long long gu64;
#define RLX_AGENT __ATOMIC_RELAXED, __HIP_MEMORY_SCOPE_AGENT
#define LDS_WAIT() asm volatile("s_waitcnt lgkmcnt(0)" ::: "memory")
#define VM_WAIT() asm volatile("s_waitcnt vmcnt(0)" ::: "memory")
__device__ __forceinline__ unsigned long long rt() { return __builtin_amdgcn_s_memrealtime(); }

#define XB_TMO      128
#define XB_XCNT(j)  (256  + 64 * (j))
#define XB_XSUB(j)  (1280 + 64 * (j))
#define XB_XGEN(j)  (2304 + 64 * (j))
#define XB_TOP      3328
#define XB_TOPGEN   3392
#define XCD_BAR_WORDS 3456
#define XB_SPIN_CAP (1u << 18)

__device__ __forceinline__ unsigned xb_ld(unsigned* p)              { return __hip_atomic_load(p, __ATOMIC_RELAXED, __HIP_MEMORY_SCOPE_AGENT); }
__device__ __forceinline__ unsigned xb_add(unsigned* p, unsigned v) { return __hip_atomic_fetch_add(p, v, __ATOMIC_RELAXED, __HIP_MEMORY_SCOPE_AGENT); }
__device__ __forceinline__ unsigned xb_xcc_id() { return (unsigned)__builtin_amdgcn_s_getreg((3 << 11) | 20) & 0xFu; }
#define XB_SPIN(cond, bar) do { unsigned _sp = 0; while (cond) { __builtin_amdgcn_s_sleep(1); \
    if ((++_sp & 255u) == 0u) { if (xb_ld(&(bar)[XB_TMO])) break; if (_sp > XB_SPIN_CAP) { atomicAdd(&(bar)[XB_TMO], 1u); break; } } } } while (0)

struct XcdBarrier {
    unsigned* bar; unsigned x;
    volatile LAS unsigned* st;
};

__device__ __forceinline__ XcdBarrier xcd_barrier_post(unsigned* bar, volatile LAS unsigned* st) {
    XcdBarrier b; b.bar = bar; b.x = xb_xcc_id(); b.st = st;
    if (threadIdx.x == 0) (void)xb_add(&bar[XB_XCNT(b.x)], 1u);
    return b;
}
__device__ __forceinline__ void xcd_barrier_complete(unsigned* bar, unsigned x, unsigned& nloc, unsigned& nx) {
    const unsigned G = gridDim.x * gridDim.y * gridDim.z;
    unsigned sum, cnt, mine, sp = 0u;
    for (;;) {
        sum = 0u; cnt = 0u; mine = 0u;
#pragma unroll
        for (unsigned j = 0; j < 16; ++j) { const unsigned c = xb_ld(&bar[XB_XCNT(j)]); sum += c; cnt += (c > 0u) ? 1u : 0u; mine = (j == x) ? c : mine; }
        if (sum == G) break;
        __builtin_amdgcn_s_sleep(1);
        if ((++sp & 255u) == 0u) { if (xb_ld(&bar[XB_TMO])) break; if (sp > XB_SPIN_CAP) { atomicAdd(&bar[XB_TMO], 1u); break; } }
    }
    nloc = mine > 0u ? mine : 1u; nx = cnt > 0u ? cnt : 1u;
}

__device__ __forceinline__ void xcd_barrier(const XcdBarrier& b) {
    asm volatile("s_waitcnt vmcnt(0)" ::: "memory");
    __syncthreads();
    if (threadIdx.x == 0) {
        unsigned* bar = b.bar;
        __builtin_amdgcn_s_waitcnt(0);
        unsigned nloc = b.st[0], nx = b.st[1];
        if (nloc == 0u) { xcd_barrier_complete(bar, b.x, nloc, nx); b.st[0] = nloc; b.st[1] = nx; }
        const unsigned old = xb_add(&bar[XB_XSUB(b.x)], 1u);
        const unsigned gen = old / nloc;
        if (old + 1u == (gen + 1u) * nloc) {
            __builtin_amdgcn_fence(__ATOMIC_RELEASE, "agent");
            asm volatile("s_waitcnt vmcnt(0)" ::: "memory");
            const unsigned og = xb_add(&bar[XB_TOP], 1u);
            const unsigned tg = og / nx;
            if (og + 1u == (tg + 1u) * nx) xb_add(&bar[XB_TOPGEN], 1u);
            else XB_SPIN(xb_ld(&bar[XB_TOPGEN]) == tg, bar);
            __builtin_amdgcn_fence(__ATOMIC_ACQUIRE, "agent");
            xb_add(&bar[XB_XGEN(b.x)], 1u);
            asm volatile("s_waitcnt vmcnt(0)" ::: "memory");
        } else {
            XB_SPIN(xb_ld(&bar[XB_XGEN(b.x)]) == gen, bar);
            __builtin_amdgcn_fence(__ATOMIC_ACQUIRE, "agent");
            asm volatile("s_waitcnt vmcnt(0)" ::: "memory");
        }
    }
    __syncthreads();
}
#include <hip/hip_bf16.h>
#include <cmath>
namespace attn_body {
using bf16=__hip_bfloat16;
using bf16x8=__attribute__((ext_vector_type(8)))short;
using s16x4=__attribute__((ext_vector_type(4)))short;
using f32x16=__attribute__((ext_vector_type(16)))float;
using u32x4=__attribute__((ext_vector_type(4)))unsigned;
using f32x4v=__attribute__((ext_vector_type(4)))float;
constexpr int BATCH=8,NHEAD=8,SEQ=4096,D=64,DM=NHEAD*D;
constexpr int NW=8,QBLK=32,QB=QBLK*NW,KVBLK=64,NQB=SEQ/QB;
constexpr int ATTN_PITCH=DM, ATTN_UNIT_ROWS=QB, OPITCH=DM;
__device__ __forceinline__ int crow(int r,int hi){return (r&3)+8*(r>>2)+4*hi;}
#define SBAR() __builtin_amdgcn_sched_barrier(0)
__device__ __forceinline__ void cmask(f32x16&p0,f32x16&p1,int jb,int qrel,int hi){
  const float NEG=-INFINITY; int kb=64*jb+4*hi;
  #pragma unroll
  for(int r=0;r<16;++r){int kv=kb+(r&3)+8*(r>>2); if(kv>qrel)p0[r]=NEG; if(kv+32>qrel)p1[r]=NEG;}
}

constexpr int NSLOT=3, SLOTB=8192;
constexpr int LDS_K=0, LDS_V=NSLOT*SLOTB, LDS_WS=2*NSLOT*SLOTB, LDS_OST=LDS_WS+NW*64*4, LDS_KM=LDS_OST+NW*4096, LDS_BYTES=LDS_KM+4096;
constexpr float C2=0.125f*1.4426950408889634f;
__device__ __forceinline__ void glds16(const void*gsrc,unsigned lds_dst){unsigned keep;
  asm volatile("s_mov_b32 %0, m0\n\ts_mov_b32 m0, %2\n\ts_nop 0\n\tglobal_load_lds_dwordx4 %1, off\n\ts_mov_b32 m0, %0":"=&s"(keep):"v"(gsrc),"s"(lds_dst):"memory");}
__device__ __forceinline__ float max3f(float a,float b,float c){float r;asm("v_max3_f32 %0, %1, %2, %3":"=v"(r):"v"(a),"v"(b),"v"(c));return r;}
__device__ __forceinline__ float max2f(float a,float b){float r;asm("v_max_f32_e32 %0, %1, %2":"=v"(r):"v"(a),"v"(b));return r;}
__device__ __forceinline__ float fadd_s(float a,float b){float r;asm("v_add_f32_e32 %0, %1, %2":"=v"(r):"v"(a),"v"(b));return r;}
__device__ __forceinline__ float fsub_s(float a,float b){float r;asm("v_sub_f32_e32 %0, %1, %2":"=v"(r):"v"(a),"v"(b));return r;}
typedef float f32x2_t __attribute__((ext_vector_type(2))); typedef __bf16 bf16x2_t __attribute__((ext_vector_type(2)));
__device__ __forceinline__ unsigned cvtpk_s(float lo,float hi){f32x2_t v={lo,hi};bf16x2_t b=__builtin_convertvector(v,bf16x2_t);return __builtin_bit_cast(unsigned,b);}
#define WAIT_BAR(N) asm volatile("s_waitcnt vmcnt(" #N ") lgkmcnt(0)\n\ts_barrier":::"memory")

__device__ __forceinline__ void qkt(f32x16&p0,f32x16&p1,const char*Kslot,const bf16x8*qr,const f32x16&negm,int r32,int hi){
  const char*kb=Kslot+hi*1024+r32*16;
  #pragma unroll
  for(int d0=0;d0<4;++d0){
    const bf16x8 b0=*reinterpret_cast<const bf16x8*>(kb+d0*2048);
    const bf16x8 b1=*reinterpret_cast<const bf16x8*>(kb+d0*2048+512);
    if(d0==0){p0=__builtin_amdgcn_mfma_f32_32x32x16_bf16(b0,qr[0],negm,0,0,0);p1=__builtin_amdgcn_mfma_f32_32x32x16_bf16(b1,qr[0],negm,0,0,0);}
    else{p0=__builtin_amdgcn_mfma_f32_32x32x16_bf16(b0,qr[d0],p0,0,0,0);p1=__builtin_amdgcn_mfma_f32_32x32x16_bf16(b1,qr[d0],p1,0,0,0);}}
}
typedef __attribute__((address_space(3))) const char* lds_cptr;
typedef short v4i16_t __attribute__((ext_vector_type(4)));
__device__ __forceinline__ void kload8(bf16x8*kf,lds_cptr kp){
  kf[0]=*(const __attribute__((address_space(3))) bf16x8*)(kp);      kf[1]=*(const __attribute__((address_space(3))) bf16x8*)(kp+512);
  kf[2]=*(const __attribute__((address_space(3))) bf16x8*)(kp+2048); kf[3]=*(const __attribute__((address_space(3))) bf16x8*)(kp+2560);
  kf[4]=*(const __attribute__((address_space(3))) bf16x8*)(kp+4096); kf[5]=*(const __attribute__((address_space(3))) bf16x8*)(kp+4608);
  kf[6]=*(const __attribute__((address_space(3))) bf16x8*)(kp+6144); kf[7]=*(const __attribute__((address_space(3))) bf16x8*)(kp+6656);
}
__device__ __forceinline__ void kload2(bf16x8*kf,lds_cptr kp,int j){ kf[2*j]=*(const __attribute__((address_space(3))) bf16x8*)(kp+j*2048); kf[2*j+1]=*(const __attribute__((address_space(3))) bf16x8*)(kp+j*2048+512); }
__device__ __forceinline__ s16x4 vtr(lds_cptr p){ return __builtin_bit_cast(s16x4,__builtin_amdgcn_ds_read_tr16_b64_v4i16((__attribute__((address_space(3))) v4i16_t*)p)); }
__device__ __forceinline__ float rowmax(const f32x16&p0,const f32x16&p1){
  float a=max3f(p0[0],p0[1],p1[0]),b=max3f(p0[2],p0[3],p1[1]);a=max3f(a,p1[2],p1[3]);
  #pragma unroll
  for(int r=4;r<16;r+=4){a=max3f(a,p0[r],p0[r+1]);b=max3f(b,p0[r+2],p0[r+3]);a=max3f(a,p1[r],p1[r+1]);b=max3f(b,p1[r+2],p1[r+3]);}
  const float m=max2f(a,b);
  auto rr=__builtin_amdgcn_permlane32_swap(__float_as_uint(m),__float_as_uint(m),false,false);
  return max2f(__uint_as_float(rr[0]),__uint_as_float(rr[1]));
}
__device__ __forceinline__ void pv(f32x16*o,int vb,bf16x8 pa0,bf16x8 pa1,bf16x8 pa2,bf16x8 pa3){
  #pragma unroll
  for(int d0=0;d0<2;++d0){s16x4 lo[4],hi[4];
    #pragma unroll
    for(int ks=0;ks<4;++ks){
      asm volatile("ds_read_b64_tr_b16 %0,%1 offset:%c2":"=&v"(lo[ks]):"v"(vb),"i"(d0*4096+ks*1024):"memory");
      asm volatile("ds_read_b64_tr_b16 %0,%1 offset:%c2":"=&v"(hi[ks]):"v"(vb),"i"(d0*4096+ks*1024+512):"memory");}
    asm volatile("s_waitcnt lgkmcnt(0)":::"memory");SBAR();
    #define PK(k) (bf16x8){lo[k][0],lo[k][1],lo[k][2],lo[k][3],hi[k][0],hi[k][1],hi[k][2],hi[k][3]}
    o[d0]=__builtin_amdgcn_mfma_f32_32x32x16_bf16(pa0,PK(0),o[d0],0,0,0);
    o[d0]=__builtin_amdgcn_mfma_f32_32x32x16_bf16(pa1,PK(1),o[d0],0,0,0);
    o[d0]=__builtin_amdgcn_mfma_f32_32x32x16_bf16(pa2,PK(2),o[d0],0,0,0);
    o[d0]=__builtin_amdgcn_mfma_f32_32x32x16_bf16(pa3,PK(3),o[d0],0,0,0);
    #undef PK
  }
}

#ifndef ATTN_STORE16
#define ATTN_STORE16(p,v) (*(u32x4*)(p)=(v))
#endif
template<int THRL> __device__ __forceinline__ void attn_unit(int b,int h,int qb,const bf16*Q,const bf16*__restrict__ K,const bf16*__restrict__ V,bf16*O,char*shm){
  const int tid=threadIdx.x,lane=tid&63,r32=lane&31,hi=lane>>5; const int wid=__builtin_amdgcn_readfirstlane(tid>>6);
  const long rowbase=(long)b*SEQ; const int q0=qb*QB;
  const bf16*Qw=Q+(rowbase+q0+wid*QBLK)*DM+h*D;
  const bf16*Kh=K+rowbase*DM+h*D,*Vh=V+rowbase*DM+h*D;
  const unsigned lds0=(unsigned)(uintptr_t)shm;
  float*wsf=(float*)(shm+LDS_WS)+wid*64;
  const bf16*ksrc=Kh+(long)lane*DM+wid*8;
  const bf16*vsrc=Vh+(long)(16*(wid&3)+(lane>>2))*DM+(wid>>2)*32+(lane&3)*8;
  const unsigned kdst=lds0+LDS_K+wid*1024, vdst=lds0+LDS_V+wid*1024;
  #define DMA_K(t,slot) glds16(ksrc+(long)(t)*KVBLK*DM,(unsigned)__builtin_amdgcn_readfirstlane(kdst+(slot)))
  #define DMA_V(t,slot) glds16(vsrc+(long)(t)*KVBLK*DM,(unsigned)__builtin_amdgcn_readfirstlane(vdst+(slot)))
  const int vb0=(int)(lds0+LDS_V)+((lane>>4)&1)*32+(lane&3)*8+(4*hi+((lane&15)>>2))*64;
  const char*Kbase=shm+LDS_K; bf16x8 kf[8];
  const lds_cptr shm3=(lds_cptr)shm; const lds_cptr kp0=shm3+LDS_K+hi*1024+r32*16; const lds_cptr vp0=shm3+LDS_V+((lane>>4)&1)*32+(lane&3)*8+(4*hi+((lane&15)>>2))*64;
  const int NT=(q0+QB)/KVBLK;
  DMA_K(0,0);DMA_V(0,0);DMA_K(1,SLOTB);
  bf16x8 qr[4];
  #pragma unroll
  for(int d0=0;d0<4;++d0)qr[d0]=*reinterpret_cast<const bf16x8*>(&Qw[(long)r32*DM+d0*16+hi*8]);
  unsigned selm=0u;
  if(qb>0){
    float q32[32];
    #pragma unroll
    for(int d0=0;d0<4;++d0){
      #pragma unroll
      for(int j=0;j<8;++j)q32[d0*8+j]=__uint_as_float(((unsigned)(unsigned short)qr[d0][j])<<16);}
    float v1=-INFINITY,v2=-INFINITY,v3=-INFINITY;int i1=0,i2=0,i3=0;
    const float*km=(const float*)(shm+LDS_KM);
    for(int n=0;n<qb;++n){
      float g=0.f;
      #pragma unroll
      for(int d0=0;d0<4;++d0){
        const f32x4v ka=*(const f32x4v*)(km+n*64+d0*16+hi*8),kb=*(const f32x4v*)(km+n*64+d0*16+hi*8+4);
        #pragma unroll
        for(int j=0;j<4;++j){g+=q32[d0*8+j]*ka[j];g+=q32[d0*8+4+j]*kb[j];}}
      {auto rr=__builtin_amdgcn_permlane32_swap(__float_as_uint(g),__float_as_uint(g),false,false);g=__uint_as_float(rr[0])+__uint_as_float(rr[1]);}
      if(g>v1){v3=v2;i3=i2;v2=v1;i2=i1;v1=g;i1=n;}else if(g>v2){v3=v2;i3=i2;v2=g;i2=n;}else if(g>v3){v3=g;i3=n;}
    }
    selm=(1u<<i1)|(qb>=2?(1u<<i2):0u)|(qb>=3?(1u<<i3):0u);
  }
  float mhat=0.f,l_reg=0.f;f32x16 o[2];o[0]=f32x16{};o[1]=f32x16{};f32x16 negm=f32x16{};asm volatile("":"+v"(negm));
  #define SETNEG(t) do{ const int t_=(t); const bool s_=(t_>=NT-4)||(((selm>>(t_>>2))&1u)!=0u); const float v_=s_?-mhat:-1e30f; \
    _Pragma("unroll") for(int r=0;r<16;++r)negm[r]=v_; asm volatile("":"+v"(negm)); }while(0)
  const int qrel=wid*QBLK+r32;
  #define CMASK(P0,P1,t) do{int jb_=(t)-(NT-4); if(jb_>=0)cmask(P0,P1,jb_,qrel,hi);}while(0)
  bool resc=false;
  #define START(P0,P1) do{ const float rm=rowmax(P0,P1); resc=false; \
    { const float dl=(rm<-1e29f)?0.f:rm; mhat=fadd_s(mhat,dl); \
      _Pragma("unroll") for(int r=0;r<16;++r){P0[r]=fsub_s(P0[r],dl);P1[r]=fsub_s(P1[r],dl);} \
      _Pragma("unroll") for(int r=0;r<16;++r)negm[r]=-mhat; asm volatile("":"+v"(negm)); } \
    _Pragma("unroll") for(int r=0;r<16;++r)P0[r]=__builtin_amdgcn_exp2f(P0[r]); }while(0)
  #define RESC() do{ if(resc){ asm volatile("s_waitcnt lgkmcnt(0)":::"memory"); \
      _Pragma("unroll") for(int d_=0;d_<2;++d_) _Pragma("unroll") for(int r=0;r<16;++r)o[d_][r]*=wsf[crow(r,hi)]; } }while(0)
  f32x16 pA0,pA1,pB0,pB1;
  int sl_prev=0,sl_cur=0,sl_next=SLOTB;
  #define ROT() do{sl_prev=sl_cur;sl_cur=sl_next;sl_next=(sl_next==(NSLOT-1)*SLOTB)?0:sl_next+SLOTB;}while(0)
  DMA_K(2,2*SLOTB);
  WAIT_BAR(3);
  SETNEG(0); qkt(pA0,pA1,Kbase,qr,negm,r32,hi);asm volatile("s_nop 15\n\ts_nop 7":"+v"(pA0),"+v"(pA1));CMASK(pA0,pA1,0);
  START(pA0,pA1);
  _Pragma("unroll") for(int r=0;r<16;++r)pA1[r]=__builtin_amdgcn_exp2f(pA1[r]);
  WAIT_BAR(0);
  DMA_K(3,0);DMA_V(1,SLOTB);
  ROT();
  kload8(kf,kp0+sl_cur);
  WAIT_BAR(2);
  s16x4 vlo[8],vhi[8]; u32x4 pw0,pw1,pw2,pw3;
  #define PKW(P,B) cvtpk_s(P[B],P[B+1])
  #define PAF(k) __builtin_bit_cast(bf16x8,pw##k)
  #define VFR(i) (bf16x8){vlo[i][0],vlo[i][1],vlo[i][2],vlo[i][3],vhi[i][0],vhi[i][1],vhi[i][2],vhi[i][3]}
  #define PIN(x) asm volatile("":"+v"(x))
  #define MX3(a,b,c) __builtin_fmaxf(__builtin_fmaxf((a),(b)),(c))
  #define GAPA(MF,A0,A1,A2,A3,W0,W1,PW) do{ MF; sacc+=A0; sacc+=A1; sacc+=A2; sacc+=A3; PIN(sacc); W0; W1; PIN(PW); SBAR(); }while(0)
  #define EX(v) __builtin_amdgcn_exp2f(v)
  #define GAPB(MF,X,B) do{ MF; X[B]=EX(X[B]); X[B+1]=EX(X[B+1]); X[B+2]=EX(X[B+2]); X[B+3]=EX(X[B+3]); PIN(X); SBAR(); }while(0)
  #define VRD(i) do{ vlo[i]=vtr(vp_+(((i)>>2)*4096+((i)&3)*1024)); vhi[i]=vtr(vp_+(((i)>>2)*4096+((i)&3)*1024+512)); }while(0)
  #define KRD(G,j) do{ if(G){ kload2(kf,kp0+sl_next,j); SBAR(); } }while(0)
  #define STEP(C0,C1,P0,P1,t,GK,GV,GL) do{ SETNEG(t); SBAR(); \
    const lds_cptr vp_=vp0+sl_prev; \
    VRD(0); SBAR(); float sacc=(P0[0]+P0[1]); \
    GAPA(C0=__builtin_amdgcn_mfma_f32_32x32x16_bf16(kf[0],qr[0],negm,0,0,0), P0[2],P0[3],P0[4],P0[5],     pw0[0]=PKW(P0,0), pw0[1]=PKW(P0,2), pw0); \
    VRD(4); SBAR(); GAPA(C1=__builtin_amdgcn_mfma_f32_32x32x16_bf16(kf[1],qr[0],negm,0,0,0), P0[6],P0[7],P0[8],P0[9],     pw0[2]=PKW(P0,4), pw0[3]=PKW(P0,6), pw0); \
    VRD(1); SBAR(); GAPA(C0=__builtin_amdgcn_mfma_f32_32x32x16_bf16(kf[2],qr[1],C0,0,0,0),   P0[10],P0[11],P0[12],P0[13], pw1[0]=PKW(P0,8), pw1[1]=PKW(P0,10), pw1); \
    VRD(5); SBAR(); GAPA(C1=__builtin_amdgcn_mfma_f32_32x32x16_bf16(kf[3],qr[1],C1,0,0,0),   P0[14],P0[15],P1[0],P1[1],   pw1[2]=PKW(P0,12),pw1[3]=PKW(P0,14), pw1); \
    VRD(2); SBAR(); GAPA(C0=__builtin_amdgcn_mfma_f32_32x32x16_bf16(kf[4],qr[2],C0,0,0,0),   P1[2],P1[3],P1[4],P1[5],     pw2[0]=PKW(P1,0), pw2[1]=PKW(P1,2), pw2); \
    VRD(6); SBAR(); GAPA(C1=__builtin_amdgcn_mfma_f32_32x32x16_bf16(kf[5],qr[2],C1,0,0,0),   P1[6],P1[7],P1[8],P1[9],     pw2[2]=PKW(P1,4), pw2[3]=PKW(P1,6), pw2); \
    VRD(3); SBAR(); GAPA(C0=__builtin_amdgcn_mfma_f32_32x32x16_bf16(kf[6],qr[3],C0,0,0,0),   P1[10],P1[11],P1[12],P1[13], pw3[0]=PKW(P1,8), pw3[1]=PKW(P1,10), pw3); \
    VRD(7); SBAR(); GAPA(C1=__builtin_amdgcn_mfma_f32_32x32x16_bf16(kf[7],qr[3],C1,0,0,0),   P1[14],P1[15],0.f,0.f,       pw3[2]=PKW(P1,12),pw3[3]=PKW(P1,14), pw3); \
    l_reg+=sacc; \
    if(GK){DMA_K((t)+3,sl_cur);} if(GV){DMA_V((t)+1,sl_next);} \
    CMASK(C0,C1,t); \
    { float a=MX3(C0[0],C0[1],C1[0]),b=MX3(C0[2],C0[3],C1[1]); a=MX3(a,C1[2],C1[3]); \
      _Pragma("unroll") for(int r=4;r<16;r+=4){a=MX3(a,C0[r],C0[r+1]);b=MX3(b,C0[r+2],C0[r+3]);a=MX3(a,C1[r],C1[r+1]);b=MX3(b,C1[r+2],C1[r+3]);} \
      float rm=__builtin_fmaxf(a,b); { auto rr=__builtin_amdgcn_permlane32_swap(__float_as_uint(rm),__float_as_uint(rm),false,false); rm=__builtin_fmaxf(__uint_as_float(rr[0]),__uint_as_float(rr[1])); } \
      resc=false; \
      if(__builtin_expect(__any(rm>(float)THRL),0)){ const float dl=__builtin_fmaxf(rm,0.f); mhat+=dl; \
        _Pragma("unroll") for(int r=0;r<16;++r){C0[r]-=dl;C1[r]-=dl;} \
        _Pragma("unroll") for(int r=0;r<16;++r)negm[r]=-mhat; asm volatile("":"+v"(negm)); \
        const float f=__builtin_amdgcn_exp2f(-dl); l_reg*=f; if(hi==0)wsf[r32]=f; resc=true; } } \
    SBAR(); \
    GAPB(o[0]=__builtin_amdgcn_mfma_f32_32x32x16_bf16(PAF(0),VFR(0),o[0],0,0,0), C0,0); \
    GAPB(o[1]=__builtin_amdgcn_mfma_f32_32x32x16_bf16(PAF(0),VFR(4),o[1],0,0,0), C0,4); \
    KRD(GL,0); GAPB(o[0]=__builtin_amdgcn_mfma_f32_32x32x16_bf16(PAF(1),VFR(1),o[0],0,0,0), C0,8); \
    KRD(GL,1); GAPB(o[1]=__builtin_amdgcn_mfma_f32_32x32x16_bf16(PAF(1),VFR(5),o[1],0,0,0), C0,12); \
    KRD(GL,2); GAPB(o[0]=__builtin_amdgcn_mfma_f32_32x32x16_bf16(PAF(2),VFR(2),o[0],0,0,0), C1,0); \
    KRD(GL,3); GAPB(o[1]=__builtin_amdgcn_mfma_f32_32x32x16_bf16(PAF(2),VFR(6),o[1],0,0,0), C1,4); \
    GAPB(o[0]=__builtin_amdgcn_mfma_f32_32x32x16_bf16(PAF(3),VFR(3),o[0],0,0,0), C1,8); \
    GAPB(o[1]=__builtin_amdgcn_mfma_f32_32x32x16_bf16(PAF(3),VFR(7),o[1],0,0,0), C1,12); \
    }while(0)
  int t=1;
  #undef CMASK
  #define CMASK(P0,P1,t) do{}while(0)
  for(;t+5<NT;t+=2){
    STEP(pB0,pB1,pA0,pA1,t,true,true,true);     WAIT_BAR(2); RESC(); ROT();
    STEP(pA0,pA1,pB0,pB1,t+1,true,true,true);   WAIT_BAR(2); RESC(); ROT();
  }
  #undef CMASK
  #define CMASK(P0,P1,t) do{int jb_=(t)-(NT-4); if(jb_>=0)cmask(P0,P1,jb_,qrel,hi);}while(0)
  #define ENDW(tt) do{ if((tt)+3<NT){WAIT_BAR(2);} else if((tt)+2<NT){WAIT_BAR(1);} else {WAIT_BAR(0);} }while(0)
  for(;t+1<NT;t+=2){
    STEP(pB0,pB1,pA0,pA1,t,(t+3<NT),(t+1<NT),(t+1<NT));       ENDW(t);   RESC(); ROT();
    STEP(pA0,pA1,pB0,pB1,t+1,(t+4<NT),(t+2<NT),(t+2<NT));     ENDW(t+1); RESC(); ROT();
  }
  STEP(pB0,pB1,pA0,pA1,NT-1,false,false,false); RESC();
  { float sacc=pB0[0]+pB0[1]; _Pragma("unroll") for(int r=2;r<16;++r)sacc+=pB0[r]; _Pragma("unroll") for(int r=0;r<16;++r)sacc+=pB1[r]; l_reg+=sacc;
    pw0=(u32x4){PKW(pB0,0),PKW(pB0,2),PKW(pB0,4),PKW(pB0,6)};pw1=(u32x4){PKW(pB0,8),PKW(pB0,10),PKW(pB0,12),PKW(pB0,14)};pw2=(u32x4){PKW(pB1,0),PKW(pB1,2),PKW(pB1,4),PKW(pB1,6)};pw3=(u32x4){PKW(pB1,8),PKW(pB1,10),PKW(pB1,12),PKW(pB1,14)};
    SBAR(); pv(o,vb0+sl_cur,PAF(0),PAF(1),PAF(2),PAF(3)); }
  #undef PKW
  #undef PAF
  #undef VFR
  #undef PIN
  #undef MX3
  #undef GAPA
  #undef GAPB
  #undef EX
  #undef VRD
  #undef KRD
  #undef STEP
  #undef ENDW
  {auto rr=__builtin_amdgcn_permlane32_swap(__float_as_uint(l_reg),__float_as_uint(l_reg),false,false);l_reg=__uint_as_float(rr[0])+__uint_as_float(rr[1]);}
  if(hi==0)wsf[32+r32]=l_reg;asm volatile("s_waitcnt lgkmcnt(0)":::"memory");
  float rli[16];
  #pragma unroll
  for(int r=0;r<16;++r)rli[r]=__builtin_amdgcn_rcpf(wsf[32+crow(r,hi)]);
  bf16*Ow=O+(rowbase+q0+wid*QBLK)*OPITCH+h*D;
  { bf16*stg=(bf16*)(shm+LDS_OST)+wid*2048;
    #pragma unroll
    for(int r=0;r<16;++r){const int orow=crow(r,hi);
      #pragma unroll
      for(int d0=0;d0<2;++d0)stg[orow*64+d0*32+r32]=__float2bfloat16(o[d0][r]*rli[r]);}
    asm volatile("s_waitcnt lgkmcnt(0)":::"memory");
    #pragma unroll
    for(int i=0;i<4;++i){const int row=i*8+(lane>>3),ch=lane&7; const u32x4 v=*(const u32x4*)(stg+row*64+ch*8); ATTN_STORE16(Ow+(long)row*OPITCH+ch*8,v);} }
  asm volatile("s_waitcnt lgkmcnt(0)\n\ts_barrier":::"memory");
  #undef SETNEG
  #undef DMA_K
  #undef DMA_V
  #undef CMASK
  #undef START
  #undef RESC
  #undef ROT
}
constexpr int ATTN_LDS_BYTES=LDS_BYTES;
struct AttnTensors { const bf16* Q; const bf16* K; const bf16* V; bf16* O; const float* kmp; };
struct AttnUnit { int bh; int qb; };
struct StaticOrder {
  int vcu, G, dbl;
  __device__ __forceinline__ explicit StaticOrder(int grid,int block,int dbl_=0):vcu((grid%8==0)?(block%8)*(grid/8)+block/8:block),G(grid),dbl(dbl_){}
  __device__ __forceinline__ bool next(int i,AttnUnit&u)const{
    i>>=dbl;
    if(G==256){ if(i>=4)return false; const int s=vcu&3; u.bh=vcu>>2; u.qb=(i==0)?15-s:(i==1)?8+s:(i==2)?7-s:s; return true; }
    const int L=i*G+vcu; if(L>=BATCH*NHEAD*NQB)return false; u.bh=L>>4; u.qb=15-(L&15); return true; }
  __device__ __forceinline__ void a_ready(const AttnUnit&)const{}
  __device__ __forceinline__ void done(const AttnUnit&)const{}
};
template<class Sched,int THRL=8> __device__ __forceinline__ void attn_phase(char*lds,const AttnTensors&T,const Sched&S){
  AttnUnit u; int bh_cur=-1;
  for(int i=0;S.next(i,u);++i){ S.a_ready(u);
    if(u.bh!=bh_cur){ bh_cur=u.bh; const int tid=threadIdx.x;
      if(tid<256){ const int n=tid>>4,seg=tid&15; const float*p0=T.kmp+((size_t)((u.bh/NHEAD)*16+n))*512+(u.bh%NHEAD)*64+seg*4;
        const f32x4v a=*(const f32x4v*)p0,b2=*(const f32x4v*)(p0+(size_t)BATCH*16*512); *(f32x4v*)(lds+LDS_KM+(n*64+seg*4)*4)=(a+b2)*(1.0f/256.0f); }
      asm volatile("s_waitcnt vmcnt(0) lgkmcnt(0)\n\ts_barrier":::"memory"); }
    attn_unit<THRL>(u.bh/NHEAD,u.bh%NHEAD,u.qb,T.Q,T.K,T.V,T.O,lds); S.done(u); }
}
#undef SBAR
#undef WAIT_BAR
}
constexpr int NWAVES = 8;
constexpr int LDS_BYTES = 160 * 1024;
constexpr int MISC_OFF = LDS_BYTES - 1024;
constexpr int CW_BAR = 4096;
constexpr int TIN = 5632;

namespace pg8 {
struct EpiProj {
    static constexpr bool PERM = true, AFTER_DRAIN = false, MIDK = false;
    unsigned char* pbase; const float2* rope; float* kmp;
    __device__ __forceinline__ void operator()(const f32x4 (&acc)[2][2][4][2], const Unit& u, int wr, int wc, int fr, int fq) const {
        const int pn = u.pn; const int row0 = u.pm * BM + wr * 64 + fr;
        if (pn < 4) {
            bf16_t* dst = (bf16_t*)(pbase + (size_t)(pn >> 1) * (32u << 20)); const float sc = pn < 2 ? C2 : 1.f; const int hcol = ((pn & 1) * 4 + wc) * 64 + 8 * fq;
            float ksl[8], ksh[8];
#pragma unroll
            for (int e = 0; e < 8; ++e) { ksl[e] = 0.f; ksh[e] = 0.f; }
#pragma unroll
            for (int ai = 0; ai < 2; ++ai)
#pragma unroll
                for (int m = 0; m < 4; ++m) {
                    const int row = row0 + ai * HALF + m * 16; const int pos = row & (SEQ - 1);
                    const float4* tp = (const float4*)(rope + pos * 32 + 8 * fq);
                    float lo[8], hi[8];
#pragma unroll
                    for (int q = 0; q < 4; ++q) { const float4 t = tp[q];
                        const int n = q >> 1, e0 = (q & 1) * 2;
                        { const float a = acc[ai][0][m][n][e0], b = acc[ai][1][m][n][e0]; lo[2 * q] = (a * t.x - b * t.y) * sc; hi[2 * q] = (b * t.x + a * t.y) * sc; }
                        { const float a = acc[ai][0][m][n][e0 + 1], b = acc[ai][1][m][n][e0 + 1]; lo[2 * q + 1] = (a * t.z - b * t.w) * sc; hi[2 * q + 1] = (b * t.z + a * t.w) * sc; } }
                    u32x4 w0, w1;
                    w0.x = cvt_pk_bf16(lo[0], lo[1]); w0.y = cvt_pk_bf16(lo[2], lo[3]); w0.z = cvt_pk_bf16(lo[4], lo[5]); w0.w = cvt_pk_bf16(lo[6], lo[7]);
                    w1.x = cvt_pk_bf16(hi[0], hi[1]); w1.y = cvt_pk_bf16(hi[2], hi[3]); w1.z = cvt_pk_bf16(hi[4], hi[5]); w1.w = cvt_pk_bf16(hi[6], hi[7]);
                    bf16_t* rp = dst + (size_t)row * 512 + hcol;
                    *(u32x4*)rp = w0; *(u32x4*)(rp + 32) = w1;
#pragma unroll
                    for (int e = 0; e < 8; ++e) { ksl[e] += lo[e]; ksh[e] += hi[e]; }
                }
            if (pn >= 2) {
#pragma unroll
                for (int e = 0; e < 8; ++e) {
#pragma unroll
                    for (int o = 1; o < 16; o <<= 1) { ksl[e] += __shfl_xor(ksl[e], o); ksh[e] += __shfl_xor(ksh[e], o); } }
                if (fr == 0) {
                    float* kp = kmp + ((size_t)((wr * NB + (u.pm >> 4)) * 16 + (u.pm & 15))) * 512 + hcol;
                    *(float4*)kp = make_float4(ksl[0], ksl[1], ksl[2], ksl[3]); *(float4*)(kp + 4) = make_float4(ksl[4], ksl[5], ksl[6], ksl[7]);
                    *(float4*)(kp + 32) = make_float4(ksh[0], ksh[1], ksh[2], ksh[3]); *(float4*)(kp + 36) = make_float4(ksh[4], ksh[5], ksh[6], ksh[7]);
                }
            }
        } else {
            if (pn >= 14) {
                unsigned char* dst8 = pbase + (size_t)(7 + 2 * ((pn - 14) >> 2)) * (32u << 20);
                const int col0 = ((pn - 14) & 3) * 256 + wc * 64 + 16 * fq;
#pragma unroll
                for (int ai = 0; ai < 2; ++ai)
#pragma unroll
                    for (int m = 0; m < 4; ++m) { unsigned char* rowp = dst8 + (size_t)(row0 + ai * HALF + m * 16) * 1024 + col0;
                        unsigned pk[4];
#pragma unroll
                        for (int bj = 0; bj < 2; ++bj) { const f32x4 v0 = acc[ai][bj][m][0], v1 = acc[ai][bj][m][1];
                            unsigned q[8];
#pragma unroll
                            for (int e = 0; e < 4; ++e) { q[e] = (unsigned)(255.f * __builtin_amdgcn_rcpf(1.f + __expf(-v0[e])) + 0.5f); q[4 + e] = (unsigned)(255.f * __builtin_amdgcn_rcpf(1.f + __expf(-v1[e])) + 0.5f); }
                            pk[2 * bj] = q[0] | (q[1] << 8) | (q[2] << 16) | (q[3] << 24); pk[2 * bj + 1] = q[4] | (q[5] << 8) | (q[6] << 16) | (q[7] << 24); }
                        *(u32x4*)rowp = (u32x4){pk[0], pk[1], pk[2], pk[3]}; }
            } else {
            bf16_t* dst; int ldc, colt; const bool sg = pn >= 12;
            dst = (bf16_t*)(pbase + (size_t)(2 + ((pn - 4) >> 1)) * (32u << 20)); ldc = 512; colt = ((pn - 4) & 1) * 256;
            const int col0 = colt + wc * 32 + 8 * fq;
#pragma unroll
            for (int ai = 0; ai < 2; ++ai)
#pragma unroll
                for (int m = 0; m < 4; ++m) { bf16_t* rowp = dst + (size_t)(row0 + ai * HALF + m * 16) * ldc + col0;
#pragma unroll
                    for (int bj = 0; bj < 2; ++bj) { f32x4 v0 = acc[ai][bj][m][0], v1 = acc[ai][bj][m][1];
                        if (sg) {
#pragma unroll
                            for (int e = 0; e < 4; ++e) { v0[e] = __builtin_amdgcn_rcpf(1.f + __expf(-v0[e])); v1[e] = __builtin_amdgcn_rcpf(1.f + __expf(-v1[e])); } }
                        u32x4 w; w.x = cvt_pk_bf16(v0[0], v0[1]); w.y = cvt_pk_bf16(v0[2], v0[3]); w.z = cvt_pk_bf16(v1[0], v1[1]); w.w = cvt_pk_bf16(v1[2], v1[3]);
                        *(u32x4*)(rowp + bj * HALF) = w; } }
            }
        }
    }
};
}

typedef float f32x4v __attribute__((ext_vector_type(4)));
struct MArgs { const float* in[17]; float* out; unsigned char* ws; int ph_lo, ph_hi, bar_region, flags; };

struct Frame {
    LAS unsigned char* lds; int tid, lane, wave, vcu, G;
};
__device__ __forceinline__ unsigned pk2(float lo, float hi) { return (unsigned)f2bf(lo) | ((unsigned)f2bf(hi) << 16); }


constexpr int WR_PITCH = 1032;
__device__ __forceinline__ unsigned cvtpk_(float lo, float hi) { typedef float f2v_ __attribute__((ext_vector_type(2))); typedef __bf16 b2v_ __attribute__((ext_vector_type(2)));
    const f2v_ v = {lo, hi}; return __builtin_bit_cast(unsigned, __builtin_convertvector(v, b2v_)); }
template <int NH>
__device__ __forceinline__ void rowproj_batch(const float* src, int row0, int lane, const LAS bf16_t* whi, const LAS bf16_t* wlo, f32x4v (&acc)[NH], float& rs) {
    const int r = lane & 15, kq = lane >> 4;
    const float* xr = src + (size_t)(row0 + r) * DM + 8 * kq;
#pragma unroll
    for (int h = 0; h < NH; ++h) acc[h] = (f32x4v){0.f, 0.f, 0.f, 0.f};
    float ssp = 0.f;
#pragma unroll 4
    for (int s = 0; s < 32; ++s) {
        const f32x4v a0 = *(const f32x4v*)(xr + 32 * s), a1 = *(const f32x4v*)(xr + 32 * s + 4);
        ssp += (a0[0] * a0[0] + a0[1] * a0[1]) + (a0[2] * a0[2] + a0[3] * a0[3]) + (a1[0] * a1[0] + a1[1] * a1[1]) + (a1[2] * a1[2] + a1[3] * a1[3]);
        v4u hv, lv;
        hv.x = cvtpk_(a0[0], a0[1]); hv.y = cvtpk_(a0[2], a0[3]); hv.z = cvtpk_(a1[0], a1[1]); hv.w = cvtpk_(a1[2], a1[3]);
        lv.x = cvtpk_(a0[0] - __uint_as_float(hv.x << 16), a0[1] - __uint_as_float(hv.x & 0xffff0000u)); lv.y = cvtpk_(a0[2] - __uint_as_float(hv.y << 16), a0[3] - __uint_as_float(hv.y & 0xffff0000u));
        lv.z = cvtpk_(a1[0] - __uint_as_float(hv.z << 16), a1[1] - __uint_as_float(hv.z & 0xffff0000u)); lv.w = cvtpk_(a1[2] - __uint_as_float(hv.w << 16), a1[3] - __uint_as_float(hv.w & 0xffff0000u));
        const bf16x8 ah = __builtin_bit_cast(bf16x8, hv), al = __builtin_bit_cast(bf16x8, lv);
#pragma unroll
        for (int h = 0; h < NH; ++h) {
            const bf16x8 bh = *(const LAS bf16x8*)(whi + (16 * h + r) * WR_PITCH + 32 * s + 8 * kq), bl = *(const LAS bf16x8*)(wlo + (16 * h + r) * WR_PITCH + 32 * s + 8 * kq);
            acc[h] = __builtin_amdgcn_mfma_f32_16x16x32_bf16(ah, bh, acc[h], 0, 0, 0);
            acc[h] = __builtin_amdgcn_mfma_f32_16x16x32_bf16(ah, bl, acc[h], 0, 0, 0);
            acc[h] = __builtin_amdgcn_mfma_f32_16x16x32_bf16(al, bh, acc[h], 0, 0, 0);
        }
    }
    ssp += __shfl_xor(ssp, 16); ssp += __shfl_xor(ssp, 32);
    rs = rsqrtf(ssp * (1.f / DM) + EPS);
}
__device__ __forceinline__ void write_norm_rows(const float* src, bf16_t* dst, int row0, int lane, float rs, const float* wn) {
    const int r = lane & 15, kq = lane >> 4;
    const float* xr = src + (size_t)(row0 + r) * DM + 8 * kq; const float* wp = wn + 8 * kq; bf16_t* dp = dst + (size_t)(row0 + r) * DM + 8 * kq;
#pragma unroll 4
    for (int s = 0; s < 32; ++s) {
        const f32x4v a0 = *(const f32x4v*)(xr + 32 * s), a1 = *(const f32x4v*)(xr + 32 * s + 4), w0 = *(const f32x4v*)(wp + 32 * s), w1 = *(const f32x4v*)(wp + 32 * s + 4);
        const f32x4v y0 = a0 * rs * w0, y1 = a1 * rs * w1;
        v4u o; o.x = cvtpk_(y0[0], y0[1]); o.y = cvtpk_(y0[2], y0[3]); o.z = cvtpk_(y1[0], y1[1]); o.w = cvtpk_(y1[2], y1[3]);
        *(v4u*)(dp + 32 * s) = o;
    }
}
__device__ __forceinline__ void write_norm_rows_f8(const float* src, unsigned char* dst, int row0, int lane, float rs, const float* wn) {
    const int r = lane & 15, kq = lane >> 4;
    const float* xr = src + (size_t)(row0 + r) * DM + 8 * kq; const float* wp = wn + 8 * kq; unsigned char* dp = dst + (size_t)(row0 + r) * DM + 8 * kq;
#pragma unroll 4
    for (int s = 0; s < 32; ++s) {
        const f32x4v a0 = *(const f32x4v*)(xr + 32 * s), a1 = *(const f32x4v*)(xr + 32 * s + 4), w0 = *(const f32x4v*)(wp + 32 * s), w1 = *(const f32x4v*)(wp + 32 * s + 4);
        const f32x4v y0 = a0 * rs * w0, y1 = a1 * rs * w1;
        int p0 = __builtin_amdgcn_cvt_pk_fp8_f32(y0[0], y0[1], 0, false); p0 = __builtin_amdgcn_cvt_pk_fp8_f32(y0[2], y0[3], p0, true);
        int p1 = __builtin_amdgcn_cvt_pk_fp8_f32(y1[0], y1[1], 0, false); p1 = __builtin_amdgcn_cvt_pk_fp8_f32(y1[2], y1[3], p1, true);
        *(uint2*)(dp + 32 * s) = make_uint2((unsigned)p0, (unsigned)p1);
    }
}

constexpr bool H_BF16 = true;
template <int NH>
__device__ __forceinline__ void rowproj_batch_bf(const bf16_t* src, int row0, int lane, const LAS bf16_t* whi, const LAS bf16_t* wlo, f32x4v (&acc)[NH], float& rs) {
    const int r = lane & 15, kq = lane >> 4;
    const bf16_t* xr = src + (size_t)(row0 + r) * DM + 8 * kq;
#pragma unroll
    for (int h = 0; h < NH; ++h) acc[h] = (f32x4v){0.f, 0.f, 0.f, 0.f};
    float ssp = 0.f;
#pragma unroll 4
    for (int s = 0; s < 32; ++s) {
        const v4u hv = *(const v4u*)(xr + 32 * s);
#pragma unroll
        for (int q = 0; q < 4; ++q) { const float a = __uint_as_float(hv[q] << 16), b = __uint_as_float(hv[q] & 0xffff0000u); ssp += a * a + b * b; }
        const bf16x8 ah = __builtin_bit_cast(bf16x8, hv);
#pragma unroll
        for (int h = 0; h < NH; ++h) {
            const bf16x8 bh = *(const LAS bf16x8*)(whi + (16 * h + r) * WR_PITCH + 32 * s + 8 * kq), bl = *(const LAS bf16x8*)(wlo + (16 * h + r) * WR_PITCH + 32 * s + 8 * kq);
            acc[h] = __builtin_amdgcn_mfma_f32_16x16x32_bf16(ah, bh, acc[h], 0, 0, 0);
            acc[h] = __builtin_amdgcn_mfma_f32_16x16x32_bf16(ah, bl, acc[h], 0, 0, 0);
        }
    }
    ssp += __shfl_xor(ssp, 16); ssp += __shfl_xor(ssp, 32);
    rs = rsqrtf(ssp * (1.f / DM) + EPS);
}
__device__ __forceinline__ void write_norm_rows_f8_bf(const bf16_t* src, unsigned char* dst, int row0, int lane, float rs, const float* wn) {
    const int r = lane & 15, kq = lane >> 4;
    const bf16_t* xr = src + (size_t)(row0 + r) * DM + 8 * kq; const float* wp = wn + 8 * kq; unsigned char* dp = dst + (size_t)(row0 + r) * DM + 8 * kq;
#pragma unroll 4
    for (int s = 0; s < 32; ++s) {
        const v4u hv = *(const v4u*)(xr + 32 * s); const f32x4v w0 = *(const f32x4v*)(wp + 32 * s), w1 = *(const f32x4v*)(wp + 32 * s + 4);
        const float y0 = __uint_as_float(hv.x << 16) * rs * w0[0], y1 = __uint_as_float(hv.x & 0xffff0000u) * rs * w0[1], y2 = __uint_as_float(hv.y << 16) * rs * w0[2], y3 = __uint_as_float(hv.y & 0xffff0000u) * rs * w0[3];
        const float y4 = __uint_as_float(hv.z << 16) * rs * w1[0], y5 = __uint_as_float(hv.z & 0xffff0000u) * rs * w1[1], y6 = __uint_as_float(hv.w << 16) * rs * w1[2], y7 = __uint_as_float(hv.w & 0xffff0000u) * rs * w1[3];
        int p0 = __builtin_amdgcn_cvt_pk_fp8_f32(y0, y1, 0, false); p0 = __builtin_amdgcn_cvt_pk_fp8_f32(y2, y3, p0, true);
        int p1 = __builtin_amdgcn_cvt_pk_fp8_f32(y4, y5, 0, false); p1 = __builtin_amdgcn_cvt_pk_fp8_f32(y6, y7, p1, true);
        *(uint2*)(dp + 32 * s) = make_uint2((unsigned)p0, (unsigned)p1);
    }
}
__device__ __forceinline__ void stage_wsplit(const float* W, int ldw, int col0, int ncols, int npad, const float* wn, LAS bf16_t* whi, LAS bf16_t* wlo, int tid) {
    const int total = 1024 * npad;
    for (int base = tid; base < total; base += 16 * NWAVES * 64) {
        float v[16], s[16];
#pragma unroll
        for (int u = 0; u < 16; ++u) { const int idx = base + u * NWAVES * 64; const int k = idx / npad, n = idx % npad; const bool ok = idx < total && n < ncols;
            v[u] = ok ? W[(size_t)k * ldw + col0 + n] : 0.f; s[u] = ok ? wn[k] : 0.f; }
#pragma unroll
        for (int u = 0; u < 16; ++u) { const int idx = base + u * NWAVES * 64; if (idx < total) { const int k = idx / npad, n = idx % npad;
            const float p = v[u] * s[u]; const unsigned short hi = f2bf(p); whi[n * WR_PITCH + k] = hi; wlo[n * WR_PITCH + k] = f2bf(p - bf2f(hi)); } }
    }
}
__device__ __forceinline__ void stage_wsplit_dense32(const float* W, const float* wn, LAS bf16_t* whi, LAS bf16_t* wlo, int tid) {
    const int n = tid & 31, k0 = tid >> 5;
    const float* wp = W + tid; const float* sp = wn + k0; LAS bf16_t* hp = whi + n * WR_PITCH + k0; LAS bf16_t* lp = wlo + n * WR_PITCH + k0;
#pragma unroll 1
    for (int b = 0; b < 8; ++b) {
        float v[8], s[8];
#pragma unroll
        for (int u = 0; u < 8; ++u) { v[u] = wp[u * 512]; s[u] = sp[u * 16]; }
#pragma unroll
        for (int u = 0; u < 8; ++u) { const float p = v[u] * s[u]; const unsigned short hi = f2bf(p); hp[u * 16] = hi; lp[u * 16] = f2bf(p - bf2f(hi)); }
        wp += 4096; sp += 128; hp += 128; lp += 128;
    }
}
__device__ __forceinline__ void stage_wsplit_gates8(const float* w_in, const float* wn, LAS bf16_t* whi, LAS bf16_t* wlo, int tid) {
    const int k0 = tid >> 1, n0 = 4 * (tid & 1);
    f32x4v v[4]; float s[4];
#pragma unroll
    for (int u = 0; u < 4; ++u) { const int k = k0 + 256 * u; v[u] = *(const f32x4v*)(w_in + (size_t)k * IN_COLS + 3584 + n0); s[u] = wn[k]; }
    {
        const v4u z = {0u, 0u, 0u, 0u};
#pragma unroll
        for (int c = 0; c < 2; ++c) { const int ch = tid + 512 * c, row = 8 + (ch >> 7), off = (ch & 127) * 8;
            *(LAS v4u*)(whi + row * WR_PITCH + off) = z; *(LAS v4u*)(wlo + row * WR_PITCH + off) = z; }
    }
#pragma unroll
    for (int u = 0; u < 4; ++u) { const int k = k0 + 256 * u;
#pragma unroll
        for (int e = 0; e < 4; ++e) { const float p = v[u][e] * s[u]; const unsigned short hi = f2bf(p); whi[(n0 + e) * WR_PITCH + k] = hi; wlo[(n0 + e) * WR_PITCH + k] = f2bf(p - bf2f(hi)); } }
}
struct P0Item { const float* src; unsigned char* dst; int ldw, pitch, f8; };
constexpr bool MOE2_FP8 = true;
constexpr bool MOE1_FP8 = true;
constexpr bool W1_PERM = true;
constexpr int I_IN = 16 * 176, I_B = 16 * 32, I_O = 16 * 32, I_1 = 32 * 16 * 64, I_2 = 32 * 16 * 32, NITEMS = I_IN + I_B + I_O + I_1 + I_2;
constexpr int NSMALL = I_IN + I_B + I_O, J_1 = 32 * 8 * 64, J_2 = 32 * 8 * 32;
__device__ __forceinline__ P0Item p0_item(int it, const MArgs& a, int lane) {
    unsigned char* ws = a.ws;
    const float* W; bf16_t* WT; int ldw, srccol0, Kd, dstrow0, k0, f8 = 0;
    int r = it;
    if (r < I_IN) { const int kb = r / 176, ng = r % 176, pn = ng >> 3, g8 = ng & 7;
        if (pn < 4) srccol0 = (pn < 2 ? 0 : 512) + 256 * (pn & 1) + 64 * (g8 & 3) + 32 * (g8 >> 2);
        else if (pn < 14) srccol0 = 1024 + 256 * (pn - 4) + 32 * g8;
        else srccol0 = 3592 + 256 * (pn - 14) + 32 * g8;
        W = a.in[2]; ldw = IN_COLS; WT = (bf16_t*)(ws + WS_WIN * MiB); Kd = 1024; dstrow0 = 32 * ng; k0 = 64 * kb; }
    else if ((r -= I_IN) < I_B) { const int kb = r >> 5, hm = kb >> 3;
        W = a.in[7] + (size_t)hm * 512 * 1024; ldw = 1024; srccol0 = 32 * (r & 31); WT = (bf16_t*)(ws + WS_WB * MiB) + (size_t)hm * 1024 * 512; Kd = 512; dstrow0 = 32 * (r & 31); k0 = 64 * (kb & 7); }
    else if ((r -= I_B) < I_O) { W = a.in[8]; ldw = 1024; srccol0 = 32 * (r & 31); WT = (bf16_t*)(ws + WS_WO * MiB); Kd = 1024; dstrow0 = 32 * (r & 31); k0 = 64 * (r >> 5); }
    else if ((r -= I_O) < I_1) { const int e = r >> 10, kb = (r >> 6) & 15, ng = r & 63;
        srccol0 = W1_PERM ? (((ng & 7) >> 2) * 1024 + 128 * (ng >> 3) + 32 * (ng & 3)) : 32 * ng;
        W = a.in[12] + (size_t)e * 1024 * 2048; ldw = 2048; WT = (bf16_t*)(ws + WS_W1 * MiB) + (size_t)e * 2048 * 1024; Kd = 1024; dstrow0 = 32 * ng; k0 = 64 * kb; f8 = MOE1_FP8 ? 1 : 0; }
    else { r -= I_1; const int e = r >> 9, kb = (r >> 5) & 15, ng = r & 31;
        W = a.in[14] + (size_t)e * 1024 * 1024; ldw = 1024; srccol0 = 32 * ng; WT = (bf16_t*)(ws + WS_W2 * MiB) + (size_t)e * 1024 * 1024; Kd = 1024; dstrow0 = 32 * ng; k0 = 64 * kb; f8 = MOE2_FP8 ? 2 : 0; }
    const int kc = lane >> 3, n4 = lane & 7;
    P0Item d; d.src = W + (size_t)(k0 + 8 * kc) * ldw + srccol0 + 4 * n4; d.ldw = ldw; d.f8 = f8;
    if (f8) { unsigned char* mat = ws + (f8 == 1 ? WS_W1 : WS_W2) * MiB; unsigned char* base8 = mat + ((size_t)((unsigned char*)WT - mat) >> 1);
        d.dst = base8 + (size_t)(dstrow0 + 4 * n4) * Kd + k0 + 8 * kc; d.pitch = Kd; }
    else { d.dst = (unsigned char*)(WT + (size_t)(dstrow0 + 4 * n4) * Kd + k0 + 8 * kc); d.pitch = Kd * 2; }
    return d;
}
__device__ __forceinline__ void p0_load(const P0Item& d, f32x4v (&r)[8]) {
#pragma unroll
    for (int j = 0; j < 8; ++j) r[j] = *(const f32x4v*)(d.src + (size_t)j * d.ldw);
}
__device__ __forceinline__ void p0_store(const P0Item& d, const f32x4v (&r)[8]) {
    if (d.f8) {
#pragma unroll
        for (int i = 0; i < 4; ++i) { int w0 = __builtin_amdgcn_cvt_pk_fp8_f32(r[0][i] * 32.f, r[1][i] * 32.f, 0, false); w0 = __builtin_amdgcn_cvt_pk_fp8_f32(r[2][i] * 32.f, r[3][i] * 32.f, w0, true);
            int w1 = __builtin_amdgcn_cvt_pk_fp8_f32(r[4][i] * 32.f, r[5][i] * 32.f, 0, false); w1 = __builtin_amdgcn_cvt_pk_fp8_f32(r[6][i] * 32.f, r[7][i] * 32.f, w1, true);
            *(uint2*)(d.dst + (size_t)i * d.pitch) = make_uint2((unsigned)w0, (unsigned)w1); }
    } else {
#pragma unroll
        for (int i = 0; i < 4; ++i) { v4u o; o.x = pk2(r[0][i], r[1][i]); o.y = pk2(r[2][i], r[3][i]); o.z = pk2(r[4][i], r[5][i]); o.w = pk2(r[6][i], r[7][i]);
            *(v4u*)(d.dst + (size_t)i * d.pitch) = o; }
    }
}

struct P8Item { const float* src; unsigned char* dst; int ldw; };
__device__ __forceinline__ P8Item p0_fp8_item(int it, const MArgs& a, int lane) {
    unsigned char* ws = a.ws;
    const float* W; unsigned char* WT; int ldw, srccol0, dstrow0, k0; bool w2perm = false;
    if (it < J_1) { const int e = it >> 9, kb = (it >> 6) & 7, ng = it & 63;
        srccol0 = ((ng & 7) >> 2) * 1024 + 128 * (ng >> 3) + 32 * (ng & 3);
        W = a.in[12] + (size_t)e * 1024 * 2048; ldw = 2048; WT = ws + WS_W1 * MiB + (size_t)e * 2048 * 1024; dstrow0 = 32 * ng; k0 = 128 * kb; }
    else { const int r = it - J_1, e = r >> 8, kb = (r >> 5) & 7, ng = r & 31;
        W = a.in[14] + (size_t)e * 1024 * 1024; ldw = 1024; srccol0 = 32 * ng; WT = ws + WS_W2 * MiB + (size_t)e * 1024 * 1024; dstrow0 = 32 * ng; k0 = 128 * kb; w2perm = true; }
    const int kc = lane >> 3, n4 = lane & 7;
    int drow = dstrow0 + 4 * n4;
    if (w2perm) { const int lt = drow & 255; drow = (drow & ~255) + 128 * ((lt >> 3) & 1) + 32 * (lt >> 6) + 8 * ((lt >> 4) & 3) + (lt & 7); }
    P8Item d; d.src = W + (size_t)(k0 + 16 * kc) * ldw + srccol0 + 4 * n4; d.dst = WT + (size_t)drow * 1024 + k0 + 16 * kc; d.ldw = ldw;
    return d;
}
__device__ __forceinline__ void p0_fp8_store(const P8Item& d, const f32x4v (&r)[16]) {
#pragma unroll
    for (int i = 0; i < 4; ++i) { v4u o;
#pragma unroll
        for (int q = 0; q < 4; ++q) { int w = __builtin_amdgcn_cvt_pk_fp8_f32(r[4 * q][i] * 32.f, r[4 * q + 1][i] * 32.f, 0, false); w = __builtin_amdgcn_cvt_pk_fp8_f32(r[4 * q + 2][i] * 32.f, r[4 * q + 3][i] * 32.f, w, true); o[q] = (unsigned)w; }
        *(v4u*)(d.dst + (size_t)i * 1024) = o; }
}
__device__ __forceinline__ void p0_fp8_weights(const Frame& F, const MArgs& a) {
    const int gw = F.vcu * NWAVES + F.wave, NGW = F.G * NWAVES;
    for (int it = gw; it < J_1 + J_2; it += 2 * NGW) {
        const bool two = it + NGW < J_1 + J_2;
        const P8Item d0 = p0_fp8_item(it, a, F.lane), d1 = p0_fp8_item(two ? it + NGW : it, a, F.lane);
        f32x4v r0[16], r1[16];
#pragma unroll
        for (int j = 0; j < 16; ++j) r0[j] = *(const f32x4v*)(d0.src + (size_t)j * d0.ldw);
#pragma unroll
        for (int j = 0; j < 16; ++j) r1[j] = *(const f32x4v*)(d1.src + (size_t)j * d1.ldw);
        p0_fp8_store(d0, r0); if (two) p0_fp8_store(d1, r1);
    }
}

struct HookOrder : pg8::StaticOrder {
    const Frame* F; const MArgs* a; int trigger; mutable int count;
    __device__ __forceinline__ void done(const pg8::Unit&) const { if (++count == trigger) p0_fp8_weights(*F, *a); }
};

struct XRows { f32x4v v[32]; };
__device__ __forceinline__ void xrows_load(XRows& R, const float* x, int bt, int lane) {
    const int r = lane & 15, kq = lane >> 4;
    const float* xr = x + (size_t)(bt * 8 + (r & 7)) * DM + 512 * (r >> 3) + 8 * kq;
#pragma unroll
    for (int s = 0; s < 16; ++s) { R.v[2 * s] = *(const f32x4v*)(xr + 32 * s); R.v[2 * s + 1] = *(const f32x4v*)(xr + 32 * s + 4); }
}
__device__ __forceinline__ void p0_batch8(const XRows& R, int bt, int lane, const LAS bf16_t* whi, const LAS bf16_t* wlo, const float* wn, const float* gbias, bf16_t* xn, float* gates) {
    const int r = lane & 15, kq = lane >> 4, half = r >> 3;
    float ssp = 0.f;
#pragma unroll
    for (int s = 0; s < 16; ++s) {
        const f32x4v a0 = R.v[2 * s], a1 = R.v[2 * s + 1];
        ssp += (a0[0] * a0[0] + a0[1] * a0[1]) + (a0[2] * a0[2] + a0[3] * a0[3]) + (a1[0] * a1[0] + a1[1] * a1[1]) + (a1[2] * a1[2] + a1[3] * a1[3]);
    }
    ssp += __shfl_xor(ssp, 16); ssp += __shfl_xor(ssp, 32); ssp += __shfl_xor(ssp, 8);
    const float rs = rsqrtf(ssp * (1.f / DM) + EPS);
    const float* wp = wn + 512 * half + 8 * kq; bf16_t* dp = xn + (size_t)(bt * 8 + (r & 7)) * DM + 512 * half + 8 * kq;
#pragma unroll
    for (int s = 0; s < 16; ++s) {
        const f32x4v a0 = R.v[2 * s], a1 = R.v[2 * s + 1], w0 = *(const f32x4v*)(wp + 32 * s), w1 = *(const f32x4v*)(wp + 32 * s + 4);
        const f32x4v y0 = a0 * rs * w0, y1 = a1 * rs * w1;
        v4u o; o.x = cvtpk_(y0[0], y0[1]); o.y = cvtpk_(y0[2], y0[3]); o.z = cvtpk_(y1[0], y1[1]); o.w = cvtpk_(y1[2], y1[3]);
        *(v4u*)(dp + 32 * s) = o;
        if ((s & 3) == 3) __builtin_amdgcn_sched_barrier(0);
    }
    f32x4v acc0 = (f32x4v){0.f, 0.f, 0.f, 0.f}, acc1 = (f32x4v){0.f, 0.f, 0.f, 0.f};
    const LAS bf16_t* bhp = whi + r * WR_PITCH + 8 * kq; const LAS bf16_t* blp = wlo + r * WR_PITCH + 8 * kq;
#pragma unroll
    for (int s = 0; s < 16; ++s) {
        const f32x4v a0 = R.v[2 * s], a1 = R.v[2 * s + 1];
        v4u hv, lv;
        hv.x = cvtpk_(a0[0], a0[1]); hv.y = cvtpk_(a0[2], a0[3]); hv.z = cvtpk_(a1[0], a1[1]); hv.w = cvtpk_(a1[2], a1[3]);
        lv.x = cvtpk_(a0[0] - __uint_as_float(hv.x << 16), a0[1] - __uint_as_float(hv.x & 0xffff0000u)); lv.y = cvtpk_(a0[2] - __uint_as_float(hv.y << 16), a0[3] - __uint_as_float(hv.y & 0xffff0000u));
        lv.z = cvtpk_(a1[0] - __uint_as_float(hv.z << 16), a1[1] - __uint_as_float(hv.z & 0xffff0000u)); lv.w = cvtpk_(a1[2] - __uint_as_float(hv.w << 16), a1[3] - __uint_as_float(hv.w & 0xffff0000u));
        const bf16x8 ah = __builtin_bit_cast(bf16x8, hv), al = __builtin_bit_cast(bf16x8, lv);
        const bf16x8 bh0 = *(const LAS bf16x8*)(bhp + 32 * s), bl0 = *(const LAS bf16x8*)(blp + 32 * s), bh1 = *(const LAS bf16x8*)(bhp + 512 + 32 * s), bl1 = *(const LAS bf16x8*)(blp + 512 + 32 * s);
        acc0 = __builtin_amdgcn_mfma_f32_16x16x32_bf16(ah, bh0, acc0, 0, 0, 0); acc0 = __builtin_amdgcn_mfma_f32_16x16x32_bf16(ah, bl0, acc0, 0, 0, 0); acc0 = __builtin_amdgcn_mfma_f32_16x16x32_bf16(al, bh0, acc0, 0, 0, 0);
        acc1 = __builtin_amdgcn_mfma_f32_16x16x32_bf16(ah, bh1, acc1, 0, 0, 0); acc1 = __builtin_amdgcn_mfma_f32_16x16x32_bf16(ah, bl1, acc1, 0, 0, 0); acc1 = __builtin_amdgcn_mfma_f32_16x16x32_bf16(al, bh1, acc1, 0, 0, 0);
        if (s & 1) __builtin_amdgcn_sched_barrier(0);
    }
    {
        const int n = lane & 15, g = lane >> 4;
#pragma unroll
        for (int i = 0; i < 4; ++i) { const float t = __shfl(acc1[i], (lane + 32) & 63); const float rsm = __shfl(rs, (4 * g + i) & 7);
            if (g < 2 && n < 8) gates[(size_t)(bt * 8 + 4 * g + i) * 8 + n] = (acc0[i] + t) * rsm + gbias[n]; }
    }
}
__device__ __forceinline__ void p0_prologue(const Frame& F, const MArgs& a) {
    unsigned char* ws = a.ws;
    const int gw = F.vcu * NWAVES + F.wave, NGW = F.G * NWAVES;
    constexpr int NBF = (MOE1_FP8 && MOE2_FP8) ? NSMALL : NITEMS;
    for (int it = gw; it < NBF; it += 2 * NGW) {
        const bool two = it + NGW < NBF;
        const P0Item d0 = p0_item(it, a, F.lane), d1 = p0_item(two ? it + NGW : it, a, F.lane);
        f32x4v r0[8], r1[8];
        p0_load(d0, r0); p0_load(d1, r1);
        p0_store(d0, r0); if (two) p0_store(d1, r1);
    }
    float2* tab = (float2*)(ws + WS_ROPE * MiB);
    for (int idx = gw * 64 + F.lane; idx < SEQ * 32; idx += NGW * 64) {
        const int pos = idx >> 5, i = idx & 31;
        const float inv = exp2f(-(float)(2 * i) * (13.287712379549449f / 64.0f));
        const float ang = (float)pos * inv;
        tab[idx] = make_float2(cosf(ang), sinf(ang));
    }
    const float* x = a.in[0]; const float* wn = a.in[1]; const float* w_in = a.in[2]; const float* gbias = a.in[5];
    LAS bf16_t* whi = (LAS bf16_t*)F.lds; LAS bf16_t* wlo = whi + 16 * WR_PITCH;
    bf16_t* xn = (bf16_t*)(ws + WS_XN * MiB); float* gates = (float*)(ws + WS_GATES * MiB);
    __syncthreads();
    for (int bt = gw; bt < T_TOK / 8; bt += NGW) { XRows R; xrows_load(R, x, bt, F.lane);
        if (bt == gw) { stage_wsplit_gates8(w_in, wn, whi, wlo, F.tid); __syncthreads(); }
        p0_batch8(R, bt, F.lane, whi, wlo, wn, gbias, xn, gates); }
}
constexpr int CNT_STRIDE = 64;
constexpr int TP_OFF = 32;
namespace pg8 {
struct GroupedOrder {
    int nN, nwg, G, c, R; const volatile PG8_LAS int* tp; const int* list; const int* cnt;
    __device__ __forceinline__ void init(int R_, int nN_, int G_, int c_, const volatile PG8_LAS int* tp_, const int* list_, const int* cnt_) { R = __builtin_amdgcn_readfirstlane(R_); nN = nN_; nwg = R * nN_; G = G_; c = c_; tp = tp_; list = list_; cnt = cnt_; }
    __device__ __forceinline__ bool next(int i, Unit& u) const {
        const long L = (long)i * G + c; if (L >= nwg) return false;
        int wgid = (int)L; { const int q = nwg / NXCD, r = nwg % NXCD, xcd = wgid % NXCD, off = wgid / NXCD; wgid = (xcd < r ? xcd * (q + 1) : r * (q + 1) + (xcd - r) * q) + off; }
        const int nig = WGM * nN, gid = wgid / nig, fm = gid * WGM, gsz = (R - fm) < WGM ? (R - fm) : WGM;
        const int pm = fm + ((wgid % nig) % gsz), pn = (wgid % nig) / gsz;
        int e = 0;
#pragma unroll
        for (int s = 16; s > 0; s >>= 1) { if (tp[e + s] <= pm) e += s; }
        e = __builtin_amdgcn_readfirstlane(e);
        u.pm = pm; u.e = e; u.rtl = pm - __builtin_amdgcn_readfirstlane(tp[e]); u.pnl = pn; u.pn = e * nN + pn; return true;
    }
    __device__ __forceinline__ bool next_lane(int i, int& pm_, int& pn_, int& e_, int& rtl_) const {
        const long L = (long)i * G + c; if (L >= nwg) return false;
        int wgid = (int)L; { const int q = nwg / NXCD, r = nwg % NXCD, xcd = wgid % NXCD, off = wgid / NXCD; wgid = (xcd < r ? xcd * (q + 1) : r * (q + 1) + (xcd - r) * q) + off; }
        const int nig = WGM * nN, gid = wgid / nig, fm = gid * WGM, gsz = (R - fm) < WGM ? (R - fm) : WGM;
        const int pm = fm + ((wgid % nig) % gsz), pn = (wgid % nig) / gsz;
        int e = 0;
#pragma unroll
        for (int s = 16; s > 0; s >>= 1) { if (tp[e + s] <= pm) e += s; }
        pm_ = pm; pn_ = pn; e_ = e; rtl_ = pm - tp[e]; return true;
    }
    __device__ __forceinline__ void gather(const Unit& u, int tid, int K, unsigned (&out)[2][2]) const {
        if (list == nullptr) {
#pragma unroll
            for (int i = 0; i < 2; ++i) { int R_, C_; stage_rc(tid * 16 + i * 8192, R_, C_);
#pragma unroll
                for (int h = 0; h < 2; ++h) out[h][i] = (unsigned)((u.pm * 256 + h * 128 + R_) * K + C_) * 2u; }
            return; }
        const int ce = cnt[u.e * CNT_STRIDE];
#pragma unroll
        for (int i = 0; i < 2; ++i) { int R_, C_; stage_rc(tid * 16 + i * 8192, R_, C_);
#pragma unroll
            for (int h = 0; h < 2; ++h) { const int pos = u.rtl * 256 + h * 128 + R_; const int tok = pos < ce ? (list[(size_t)u.e * T_TOK + pos] >> 2) : 0;
                out[h][i] = (unsigned)(tok * K + C_) * 2u; } }
    }
    __device__ __forceinline__ void a_ready(const Unit&) const {}
    __device__ __forceinline__ void done(const Unit&) const {}
};
constexpr int UT_OFF = 131072, UT_MAXU = 24, UT_TOK_OFF = UT_OFF + 1024;
struct TableOrder {
    const volatile PG8_LAS int* tab; const volatile PG8_LAS int* toks; int n;
    __device__ __forceinline__ bool next(int i, Unit& u) const {
        if (i >= n) return false;
        u.pm = __builtin_amdgcn_readfirstlane(tab[i * 8]); u.pn = __builtin_amdgcn_readfirstlane(tab[i * 8 + 1]); u.e = __builtin_amdgcn_readfirstlane(tab[i * 8 + 2]);
        u.pnl = __builtin_amdgcn_readfirstlane(tab[i * 8 + 3]); u.rtl = __builtin_amdgcn_readfirstlane(tab[i * 8 + 4]); u.ui = i; return true;
    }
    __device__ __forceinline__ void gather(const Unit& u, int tid, int K, unsigned (&out)[2][2]) const {
#pragma unroll
        for (int i = 0; i < 2; ++i) { int R_, C_; stage_rc(tid * 16 + i * 8192, R_, C_);
#pragma unroll
            for (int h = 0; h < 2; ++h) { const int row = toks ? toks[u.ui * 256 + h * 128 + R_] : u.pm * 256 + h * 128 + R_; out[h][i] = (unsigned)(row * K + C_) * 2u; } }
    }
    __device__ __forceinline__ void a_ready(const Unit&) const {}
    __device__ __forceinline__ void done(const Unit&) const {}
};
struct EpiMlp1 {
    static constexpr bool PERM = true, AFTER_DRAIN = false, MIDK = false;
    const float* b1; bf16_t* act;
    __device__ __forceinline__ void operator()(const f32x4 (&acc)[2][2][4][2], const Unit& u, int wr, int wc, int fr, int fq) const {
        const int row0 = u.pm * BM + wr * 64 + fr, j0 = u.pnl * 128 + wc * 32 + 8 * fq;
        const float4* bp = (const float4*)(b1 + (size_t)u.e * 2048 + j0);
        const float4 bg0 = bp[0], bg1 = bp[1], bl0 = bp[256], bl1 = bp[257];
        const float bg[8] = {bg0.x, bg0.y, bg0.z, bg0.w, bg1.x, bg1.y, bg1.z, bg1.w}, bl[8] = {bl0.x, bl0.y, bl0.z, bl0.w, bl1.x, bl1.y, bl1.z, bl1.w};
#pragma unroll
        for (int ai = 0; ai < 2; ++ai)
#pragma unroll
            for (int m = 0; m < 4; ++m) {
                float o[8];
#pragma unroll
                for (int n = 0; n < 2; ++n)
#pragma unroll
                    for (int e = 0; e < 4; ++e) {
                        const float gl = fminf(acc[ai][0][m][n][e] + bg[4 * n + e], 7.f);
                        const float li = fminf(fmaxf(acc[ai][1][m][n][e] + bl[4 * n + e], -7.f), 7.f);
                        o[4 * n + e] = gl * __builtin_amdgcn_rcpf(1.f + __expf(-1.702f * gl)) * (li + 1.f); }
                if (MOE2_FP8) {
                    int p0 = __builtin_amdgcn_cvt_pk_fp8_f32(o[0], o[1], 0, false); p0 = __builtin_amdgcn_cvt_pk_fp8_f32(o[2], o[3], p0, true);
                    int p1 = __builtin_amdgcn_cvt_pk_fp8_f32(o[4], o[5], 0, false); p1 = __builtin_amdgcn_cvt_pk_fp8_f32(o[6], o[7], p1, true);
                    *(uint2*)((unsigned char*)act + (size_t)(row0 + ai * HALF + m * 16) * 1024 + j0) = make_uint2((unsigned)p0, (unsigned)p1);
                } else {
                u32x4 w; w.x = cvt_pk_bf16(o[0], o[1]); w.y = cvt_pk_bf16(o[2], o[3]); w.z = cvt_pk_bf16(o[4], o[5]); w.w = cvt_pk_bf16(o[6], o[7]);
                *(u32x4*)(act + (size_t)(row0 + ai * HALF + m * 16) * 1024 + j0) = w; }
            }
    }
};
constexpr bool Y_FP8 = true;
struct EpiMlp2 {
    static constexpr bool PERM = true, AFTER_DRAIN = false, MIDK = false;
    const float* b2; bf16_t* y; const volatile PG8_LAS int* dest;
    __device__ __forceinline__ void operator()(const f32x4 (&acc)[2][2][4][2], const Unit& u, int wr, int wc, int fr, int fq) const {
        const int r0 = wr * 64 + fr, c0 = Y_FP8 ? u.pnl * 256 + wc * 64 + 16 * fq : u.pnl * 256 + wc * 32 + 8 * fq;
        const volatile PG8_LAS int* lp = dest + u.ui * 256;
        f32x4 bv[2][2];
#pragma unroll
        for (int bj = 0; bj < 2; ++bj)
#pragma unroll
            for (int n = 0; n < 2; ++n) bv[bj][n] = *(const f32x4*)(b2 + (size_t)u.e * 1024 + c0 + (Y_FP8 ? bj * 8 : bj * HALF) + 4 * n);
#pragma unroll
        for (int ai = 0; ai < 2; ++ai)
#pragma unroll
            for (int m = 0; m < 4; ++m) { const int r = r0 + ai * HALF + m * 16;
                const int dr = lp[r];
                if (dr >= 0) {
                    if (Y_FP8) { unsigned char* rowp = (unsigned char*)y + (size_t)dr * 1024 + c0;
                        unsigned pk[4];
#pragma unroll
                        for (int bj = 0; bj < 2; ++bj) { const f32x4 v0 = acc[ai][bj][m][0] + bv[bj][0], v1 = acc[ai][bj][m][1] + bv[bj][1];
                            int p0 = __builtin_amdgcn_cvt_pk_fp8_f32(v0[0], v0[1], 0, false); p0 = __builtin_amdgcn_cvt_pk_fp8_f32(v0[2], v0[3], p0, true);
                            int p1 = __builtin_amdgcn_cvt_pk_fp8_f32(v1[0], v1[1], 0, false); p1 = __builtin_amdgcn_cvt_pk_fp8_f32(v1[2], v1[3], p1, true);
                            pk[2 * bj] = (unsigned)p0; pk[2 * bj + 1] = (unsigned)p1; }
                        *(u32x4*)rowp = (u32x4){pk[0], pk[1], pk[2], pk[3]};
                    } else { bf16_t* rowp = y + (size_t)dr * 1024 + c0;
#pragma unroll
                    for (int bj = 0; bj < 2; ++bj) { const f32x4 v0 = acc[ai][bj][m][0] + bv[bj][0], v1 = acc[ai][bj][m][1] + bv[bj][1];
                        u32x4 w; w.x = cvt_pk_bf16(v0[0], v0[1]); w.y = cvt_pk_bf16(v0[2], v0[3]); w.z = cvt_pk_bf16(v1[0], v1[1]); w.w = cvt_pk_bf16(v1[2], v1[3]);
                        *(u32x4*)(rowp + bj * HALF) = w; } } } }
    }
};
}

typedef __bf16 bf2v __attribute__((ext_vector_type(2)));
struct HRows { v4u v[32]; };
__device__ __forceinline__ void hrows_load(HRows& R, const bf16_t* src, int row0, int lane) {
    const bf16_t* xr = src + (size_t)(row0 + (lane & 15)) * DM + 16 * (lane >> 4);
#pragma unroll
    for (int j = 0; j < 16; ++j) { R.v[2 * j] = *(const v4u*)(xr + 64 * j); R.v[2 * j + 1] = *(const v4u*)(xr + 64 * j + 8); }
}
__device__ __forceinline__ void router_round_regs(const Frame& F, int bt, bool valid, const HRows& R, const float* wn, const LAS bf16_t* whi, const LAS bf16_t* wlo, LAS float* lgs, LAS int* hist, LAS int* hbase,
                                                  const float* br, unsigned char* xn2, int* cnt, int* asg_e, int* asg_pos, float* asg_g, int* list) {
    const int lane = F.lane, row0 = bt * 16;
    int ti[4] = {0, 0, 0, 0}, lpos[4] = {0, 0, 0, 0}; float gq[4] = {0.f, 0.f, 0.f, 0.f};
    if (F.tid < 32) hist[F.tid] = 0;
    __syncthreads();
    if (valid) {
        const int r = lane & 15, kq = lane >> 4;
        f32x4v acc[2] = {(f32x4v){0.f, 0.f, 0.f, 0.f}, (f32x4v){0.f, 0.f, 0.f, 0.f}}; float ssp = 0.f;
#pragma unroll
        for (int s = 0; s < 32; ++s) {
            const v4u hv = R.v[s];
#pragma unroll
            for (int q = 0; q < 4; ++q) { const float a = __uint_as_float(hv[q] << 16), b = __uint_as_float(hv[q] & 0xffff0000u); ssp += a * a + b * b; }
            const bf16x8 ah = __builtin_bit_cast(bf16x8, hv);
#pragma unroll
            for (int h = 0; h < 2; ++h) {
                const int ko = 64 * (s >> 1) + 16 * kq + 8 * (s & 1);
                const bf16x8 bh = *(const LAS bf16x8*)(whi + (16 * h + r) * WR_PITCH + ko), bl = *(const LAS bf16x8*)(wlo + (16 * h + r) * WR_PITCH + ko);
                acc[h] = __builtin_amdgcn_mfma_f32_16x16x32_bf16(ah, bh, acc[h], 0, 0, 0);
                acc[h] = __builtin_amdgcn_mfma_f32_16x16x32_bf16(ah, bl, acc[h], 0, 0, 0);
            }
            if ((s & 3) == 3) __builtin_amdgcn_sched_barrier(0);
        }
        ssp += __shfl_xor(ssp, 16); ssp += __shfl_xor(ssp, 32);
        const float rs = rsqrtf(ssp * (1.f / DM) + EPS);
        {
            const float* wp = wn + 16 * kq; unsigned char* dp = xn2 + (size_t)(row0 + r) * DM + 16 * kq;
#pragma unroll
            for (int j = 0; j < 16; ++j) {
                unsigned pk[4];
#pragma unroll
                for (int o = 0; o < 2; ++o) {
                    v4u hv = R.v[2 * j + o]; const f32x4v w0 = *(const f32x4v*)(wp + 64 * j + 8 * o), w1 = *(const f32x4v*)(wp + 64 * j + 8 * o + 4);
                    asm volatile("" : "+v"(hv));
                    const float y0 = __uint_as_float(hv.x << 16) * rs * w0[0], y1 = __uint_as_float(hv.x & 0xffff0000u) * rs * w0[1], y2 = __uint_as_float(hv.y << 16) * rs * w0[2], y3 = __uint_as_float(hv.y & 0xffff0000u) * rs * w0[3];
                    const float y4 = __uint_as_float(hv.z << 16) * rs * w1[0], y5 = __uint_as_float(hv.z & 0xffff0000u) * rs * w1[1], y6 = __uint_as_float(hv.w << 16) * rs * w1[2], y7 = __uint_as_float(hv.w & 0xffff0000u) * rs * w1[3];
                    int p0 = __builtin_amdgcn_cvt_pk_fp8_f32(y0, y1, 0, false); p0 = __builtin_amdgcn_cvt_pk_fp8_f32(y2, y3, p0, true);
                    int p1 = __builtin_amdgcn_cvt_pk_fp8_f32(y4, y5, 0, false); p1 = __builtin_amdgcn_cvt_pk_fp8_f32(y6, y7, p1, true);
                    pk[2 * o] = (unsigned)p0; pk[2 * o + 1] = (unsigned)p1;
                }
                *(v4u*)(dp + 64 * j) = (v4u){pk[0], pk[1], pk[2], pk[3]};
                __builtin_amdgcn_sched_barrier(0);
            }
        }
        const int n = lane & 15, m0 = 4 * (lane >> 4);
        const float b0 = br[n], b1 = br[16 + n];
#pragma unroll
        for (int i = 0; i < 4; ++i) { const float rsm = __shfl(rs, m0 + i); lgs[(m0 + i) * 32 + n] = acc[0][i] * rsm + b0; lgs[(m0 + i) * 32 + 16 + n] = acc[1][i] * rsm + b1; }
        asm volatile("s_waitcnt lgkmcnt(0)" ::: "memory");
        if (lane < 16) {
            float lg[32];
#pragma unroll
            for (int q = 0; q < 8; ++q) { const f32x4v t = *(const LAS f32x4v*)(lgs + lane * 32 + 4 * q); lg[4 * q] = t[0]; lg[4 * q + 1] = t[1]; lg[4 * q + 2] = t[2]; lg[4 * q + 3] = t[3]; }
            float tv[4];
#pragma unroll
            for (int k = 0; k < 4; ++k) {
                float bv = -INFINITY; int bi = 0;
#pragma unroll
                for (int e = 0; e < 32; ++e) if (lg[e] > bv) { bv = lg[e]; bi = e; }
#pragma unroll
                for (int e = 0; e < 32; ++e) if (e == bi) lg[e] = -INFINITY;
                tv[k] = bv; ti[k] = bi;
            }
            const float e1 = __expf(tv[1] - tv[0]), e2 = __expf(tv[2] - tv[0]), e3 = __expf(tv[3] - tv[0]); const float inv = 1.f / (1.f + e1 + e2 + e3);
            gq[0] = inv; gq[1] = e1 * inv; gq[2] = e2 * inv; gq[3] = e3 * inv;
#pragma unroll
            for (int k = 0; k < 4; ++k) lpos[k] = atomicAdd((int*)(hist + ti[k]), 1);
        }
    }
    __syncthreads();
    if (F.tid < 32) { const int c = hist[F.tid]; hbase[F.tid] = c ? atomicAdd(&cnt[F.tid * CNT_STRIDE], c) : 0; }
    __syncthreads();
    if (valid && lane < 16) {
        const int row = row0 + lane; int pos[4];
#pragma unroll
        for (int k = 0; k < 4; ++k) pos[k] = hbase[ti[k]] + lpos[k];
        *(int4*)(asg_e + row * 4) = make_int4(ti[0], ti[1], ti[2], ti[3]);
        *(int4*)(asg_pos + row * 4) = make_int4(pos[0], pos[1], pos[2], pos[3]);
        *(float4*)(asg_g + row * 4) = make_float4(gq[0], gq[1], gq[2], gq[3]);
#pragma unroll
        for (int k = 0; k < 4; ++k) list[(size_t)ti[k] * T_TOK + pos[k]] = row * 4 + k;
    }
}
__device__ __forceinline__ void router_round(const Frame& F, int bt, bool valid, const float* hbuf, const float* wn, const LAS bf16_t* whi, const LAS bf16_t* wlo, LAS float* lgs, LAS int* hist, LAS int* hbase,
                                             const float* br, bf16_t* xn2, int* cnt, int* asg_e, int* asg_pos, float* asg_g, int* list) {
    const int lane = F.lane, row0 = bt * 16;
    float rs = 0.f; int ti[4] = {0, 0, 0, 0}, lpos[4] = {0, 0, 0, 0}; float gq[4] = {0.f, 0.f, 0.f, 0.f};
    if (F.tid < 32) hist[F.tid] = 0;
    __syncthreads();
    if (valid) {
        f32x4v acc[2];
        if (H_BF16) rowproj_batch_bf<2>((const bf16_t*)hbuf, row0, lane, whi, wlo, acc, rs); else rowproj_batch<2>(hbuf, row0, lane, whi, wlo, acc, rs);
        const int n = lane & 15, m0 = 4 * (lane >> 4);
        const float b0 = br[n], b1 = br[16 + n];
#pragma unroll
        for (int i = 0; i < 4; ++i) { const float rsm = __shfl(rs, m0 + i); lgs[(m0 + i) * 32 + n] = acc[0][i] * rsm + b0; lgs[(m0 + i) * 32 + 16 + n] = acc[1][i] * rsm + b1; }
        asm volatile("s_waitcnt lgkmcnt(0)" ::: "memory");
        if (lane < 16) {
            float lg[32];
#pragma unroll
            for (int q = 0; q < 8; ++q) { const f32x4v t = *(const LAS f32x4v*)(lgs + lane * 32 + 4 * q); lg[4 * q] = t[0]; lg[4 * q + 1] = t[1]; lg[4 * q + 2] = t[2]; lg[4 * q + 3] = t[3]; }
            float tv[4];
#pragma unroll
            for (int k = 0; k < 4; ++k) {
                float bv = -INFINITY; int bi = 0;
#pragma unroll
                for (int e = 0; e < 32; ++e) if (lg[e] > bv) { bv = lg[e]; bi = e; }
#pragma unroll
                for (int e = 0; e < 32; ++e) if (e == bi) lg[e] = -INFINITY;
                tv[k] = bv; ti[k] = bi;
            }
            const float e1 = __expf(tv[1] - tv[0]), e2 = __expf(tv[2] - tv[0]), e3 = __expf(tv[3] - tv[0]); const float inv = 1.f / (1.f + e1 + e2 + e3);
            gq[0] = inv; gq[1] = e1 * inv; gq[2] = e2 * inv; gq[3] = e3 * inv;
#pragma unroll
            for (int k = 0; k < 4; ++k) lpos[k] = atomicAdd((int*)(hist + ti[k]), 1);
        }
    }
    __syncthreads();
    if (F.tid < 32) { const int c = hist[F.tid]; hbase[F.tid] = c ? atomicAdd(&cnt[F.tid * CNT_STRIDE], c) : 0; }
    __syncthreads();
    if (valid) {
        if (lane < 16) {
            const int row = row0 + lane; int pos[4];
#pragma unroll
            for (int k = 0; k < 4; ++k) pos[k] = hbase[ti[k]] + lpos[k];
            *(int4*)(asg_e + row * 4) = make_int4(ti[0], ti[1], ti[2], ti[3]);
            *(int4*)(asg_pos + row * 4) = make_int4(pos[0], pos[1], pos[2], pos[3]);
            *(float4*)(asg_g + row * 4) = make_float4(gq[0], gq[1], gq[2], gq[3]);
#pragma unroll
            for (int k = 0; k < 4; ++k) list[(size_t)ti[k] * T_TOK + pos[k]] = row * 4 + k;
        }
        if (H_BF16) write_norm_rows_f8_bf((const bf16_t*)hbuf, (unsigned char*)xn2, row0, lane, rs, wn);
        else if (MOE1_FP8) write_norm_rows_f8(hbuf, (unsigned char*)xn2, row0, lane, rs, wn); else write_norm_rows(hbuf, xn2, row0, lane, rs, wn);
    }
}
__device__ __forceinline__ void final_row(int row, int lane, const bf16_t* hbuf, const bf16_t* y, const float* asg_g, const float* wf, float* out, float dscale) {
    const float4 gv = *(const float4*)(asg_g + row * 4);
    v4u hq[2], y0[2], y1[2], y2[2], y3[2];
    const bf16_t* yr = y + (size_t)row * 4 * DM;
#pragma unroll
    for (int j = 0; j < 2; ++j) { const int c = 8 * (lane + 64 * j);
        hq[j] = __builtin_nontemporal_load((const v4u*)(hbuf + (size_t)row * DM + c));
        y0[j] = __builtin_nontemporal_load((const v4u*)(yr + c)); y1[j] = __builtin_nontemporal_load((const v4u*)(yr + DM + c)); y2[j] = __builtin_nontemporal_load((const v4u*)(yr + 2 * DM + c)); y3[j] = __builtin_nontemporal_load((const v4u*)(yr + 3 * DM + c)); }
    float v[2][8]; float ss = 0.f;
#pragma unroll
    for (int j = 0; j < 2; ++j)
#pragma unroll
        for (int q = 0; q < 4; ++q) {
            float a = __uint_as_float(hq[j][q] << 16), b = __uint_as_float(hq[j][q] & 0xffff0000u);
            a += gv.x * __uint_as_float(y0[j][q] << 16) + gv.y * __uint_as_float(y1[j][q] << 16) + gv.z * __uint_as_float(y2[j][q] << 16) + gv.w * __uint_as_float(y3[j][q] << 16);
            b += gv.x * __uint_as_float(y0[j][q] & 0xffff0000u) + gv.y * __uint_as_float(y1[j][q] & 0xffff0000u) + gv.z * __uint_as_float(y2[j][q] & 0xffff0000u) + gv.w * __uint_as_float(y3[j][q] & 0xffff0000u);
            v[j][2 * q] = a; v[j][2 * q + 1] = b; ss += a * a + b * b; }
    ss = wave_sum(ss); const float rs = rsqrtf(ss * (1.f / DM) + EPS) * dscale;
#pragma unroll
    for (int j = 0; j < 2; ++j) { const int c = 8 * (lane + 64 * j); const float4 w0 = *(const float4*)(wf + c), w1 = *(const float4*)(wf + c + 4);
        __builtin_nontemporal_store((f32x4v){v[j][0] * rs * w0.x, v[j][1] * rs * w0.y, v[j][2] * rs * w0.z, v[j][3] * rs * w0.w}, (f32x4v*)(out + (size_t)row * DM + c));
        __builtin_nontemporal_store((f32x4v){v[j][4] * rs * w1.x, v[j][5] * rs * w1.y, v[j][6] * rs * w1.z, v[j][7] * rs * w1.w}, (f32x4v*)(out + (size_t)row * DM + c + 4)); }
}
typedef float f32x2v __attribute__((ext_vector_type(2)));
__device__ __forceinline__ void final_row_f8(int row, int lane, const bf16_t* hbuf, const unsigned char* y8, const float* asg_g, const f32x4v (&wfv)[4], float* out, float dscale, LAS float* tile) {
    const float4 gv = *(const float4*)(asg_g + row * 4);
    const unsigned char* yr = y8 + (size_t)row * 4 * DM + 16 * lane;
    const v4u ya = *(const v4u*)yr, yb = *(const v4u*)(yr + DM), yc = *(const v4u*)(yr + 2 * DM), yd = *(const v4u*)(yr + 3 * DM);
    const v4u h0 = *(const v4u*)(hbuf + (size_t)row * DM + 16 * lane), h1 = *(const v4u*)(hbuf + (size_t)row * DM + 16 * lane + 8);
    float ss = 0.f;
#pragma unroll
    for (int q = 0; q < 4; ++q) {
        const f32x2v a0 = __builtin_amdgcn_cvt_pk_f32_fp8((int)ya[q], false), a1 = __builtin_amdgcn_cvt_pk_f32_fp8((int)ya[q], true);
        const f32x2v b0 = __builtin_amdgcn_cvt_pk_f32_fp8((int)yb[q], false), b1 = __builtin_amdgcn_cvt_pk_f32_fp8((int)yb[q], true);
        const f32x2v c0 = __builtin_amdgcn_cvt_pk_f32_fp8((int)yc[q], false), c1 = __builtin_amdgcn_cvt_pk_f32_fp8((int)yc[q], true);
        const f32x2v d0 = __builtin_amdgcn_cvt_pk_f32_fp8((int)yd[q], false), d1 = __builtin_amdgcn_cvt_pk_f32_fp8((int)yd[q], true);
        const unsigned hw0 = (q < 2) ? h0[2 * q] : h1[2 * q - 4], hw1 = (q < 2) ? h0[2 * q + 1] : h1[2 * q - 3];
        f32x4v v;
        v[0] = __uint_as_float(hw0 << 16) + gv.x * a0[0] + gv.y * b0[0] + gv.z * c0[0] + gv.w * d0[0];
        v[1] = __uint_as_float(hw0 & 0xffff0000u) + gv.x * a0[1] + gv.y * b0[1] + gv.z * c0[1] + gv.w * d0[1];
        v[2] = __uint_as_float(hw1 << 16) + gv.x * a1[0] + gv.y * b1[0] + gv.z * c1[0] + gv.w * d1[0];
        v[3] = __uint_as_float(hw1 & 0xffff0000u) + gv.x * a1[1] + gv.y * b1[1] + gv.z * c1[1] + gv.w * d1[1];
        ss += (v[0] * v[0] + v[1] * v[1]) + (v[2] * v[2] + v[3] * v[3]);
        *(LAS f32x4v*)(tile + 16 * lane + 4 * q) = v;
    }
    ss = wave_sum(ss); const float rs = rsqrtf(ss * (1.f / DM) + EPS) * dscale;
    asm volatile("s_waitcnt lgkmcnt(0)" ::: "memory");
#pragma unroll
    for (int q = 0; q < 4; ++q) { const f32x4v v = *(const LAS f32x4v*)(tile + 256 * q + 4 * lane), w = wfv[q];
        pg8::st16_wt(out + (size_t)row * DM + 256 * q + 4 * lane, __builtin_bit_cast(pg8::u32x4, v * rs * w)); }
    asm volatile("s_waitcnt lgkmcnt(0)" ::: "memory");
}
__device__ __forceinline__ void moe_prefix(const Frame& F, const int* cnt, volatile LAS int* tp) {
    __syncthreads();
    if (F.wave == 0) {
        const int t = F.lane < 32 ? (cnt[(F.lane & 31) * CNT_STRIDE] + 255) >> 8 : 0;
        int inc = t;
#pragma unroll
        for (int o = 1; o < 32; o <<= 1) { const int v = __shfl_up(inc, o); if (F.lane >= o) inc += v; }
        if (F.lane < 32) tp[F.lane] = inc - t;
        if (F.lane == 31) tp[32] = inc;
    }
    __syncthreads();
}
namespace pg8 {
template <bool SECOND> struct EpiBranch {
    static constexpr bool PERM = true, AFTER_DRAIN = false, MIDK = false;
    const unsigned char* gate; bf16_t* merged; bf16_t* part;
    __device__ __forceinline__ void operator()(const f32x4 (&acc)[2][2][4][2], const Unit& u, int wr, int wc, int fr, int fq) const {
        const int row0 = u.pm * BM + wr * 64 + fr, c0 = u.pn * 256 + wc * 32 + 8 * fq, g0 = u.pn * 256 + wc * 64 + 16 * fq;
#pragma unroll
        for (int ai = 0; ai < 2; ++ai) {
            u32x4 g4[4], pv[4][2];
#pragma unroll
            for (int m = 0; m < 4; ++m) { const size_t roff = (size_t)(row0 + ai * HALF + m * 16) * 1024;
                g4[m] = *(const u32x4*)(gate + roff + g0);
                if (SECOND) { pv[m][0] = *(const u32x4*)(part + roff + g0); pv[m][1] = *(const u32x4*)(part + roff + g0 + 8); } }
#pragma unroll
            for (int m = 0; m < 4; ++m) { const size_t roff = (size_t)(row0 + ai * HALF + m * 16) * 1024;
#pragma unroll
                for (int bj = 0; bj < 2; ++bj) {
                    const unsigned gx = g4[m][2 * bj], gy = g4[m][2 * bj + 1];
                    float o[8];
#pragma unroll
                    for (int e = 0; e < 4; ++e) { o[e] = (float)((gx >> (8 * e)) & 0xffu) * (1.f / 255.f) * acc[ai][bj][m][0][e]; o[4 + e] = (float)((gy >> (8 * e)) & 0xffu) * (1.f / 255.f) * acc[ai][bj][m][1][e]; }
                    if (SECOND) {
#pragma unroll
                        for (int q = 0; q < 4; ++q) { o[2 * q] += __uint_as_float(pv[m][bj][q] << 16); o[2 * q + 1] += __uint_as_float(pv[m][bj][q] & 0xffff0000u); } }
                    u32x4 w; w.x = cvt_pk_bf16(o[0], o[1]); w.y = cvt_pk_bf16(o[2], o[3]); w.z = cvt_pk_bf16(o[4], o[5]); w.w = cvt_pk_bf16(o[6], o[7]);
                    if (SECOND) *(u32x4*)(merged + roff + c0 + bj * HALF) = w; else *(u32x4*)(part + roff + g0 + 8 * bj) = w; } }
        }
    }
};
struct EpiOutRes {
    static constexpr bool PERM = true, AFTER_DRAIN = false, MIDK = false;
    const float* x; bf16_t* h;
    __device__ __forceinline__ void operator()(const f32x4 (&acc)[2][2][4][2], const Unit& u, int wr, int wc, int fr, int fq) const {
        const int row0 = u.pm * BM + wr * 64 + fr, c0 = u.pn * 256 + wc * 32 + 8 * fq;
#pragma unroll
        for (int ai = 0; ai < 2; ++ai) {
            f32x4 xv[4][2][2];
#pragma unroll
            for (int m = 0; m < 4; ++m)
#pragma unroll
                for (int bj = 0; bj < 2; ++bj) { const size_t off = (size_t)(row0 + ai * HALF + m * 16) * 1024 + c0 + bj * HALF;
                    xv[m][bj][0] = *(const f32x4*)(x + off); xv[m][bj][1] = *(const f32x4*)(x + off + 4); }
#pragma unroll
            for (int m = 0; m < 4; ++m)
#pragma unroll
                for (int bj = 0; bj < 2; ++bj) { const size_t off = (size_t)(row0 + ai * HALF + m * 16) * 1024 + c0 + bj * HALF;
                    const f32x4 v0 = xv[m][bj][0] + acc[ai][bj][m][0], v1 = xv[m][bj][1] + acc[ai][bj][m][1];
                    u32x4 w; w.x = cvt_pk_bf16(v0[0], v0[1]); w.y = cvt_pk_bf16(v0[2], v0[3]); w.z = cvt_pk_bf16(v1[0], v1[1]); w.w = cvt_pk_bf16(v1[2], v1[3]);
                    *(u32x4*)(h + off) = w; }
        }
    }
};
}

__device__ __forceinline__ int moe_build_tables(const Frame& F, const pg8::GroupedOrder& S, int mode, const int* list) {
    LAS int* tab = (LAS int*)(F.lds + pg8::UT_OFF); LAS int* toks = (LAS int*)(F.lds + pg8::UT_TOK_OFF);
    const int need = (S.nwg + S.G - 1) / S.G;
    if (need > pg8::UT_MAXU) return -1;
    __syncthreads();
    if (F.wave == 0) {
        int pm = 0, pn = 0, e = 0, rtl = 0; const bool ok = F.lane < pg8::UT_MAXU && S.next_lane(F.lane, pm, pn, e, rtl);
        if (ok) { tab[F.lane * 8] = pm; tab[F.lane * 8 + 1] = e * S.nN + pn; tab[F.lane * 8 + 2] = e; tab[F.lane * 8 + 3] = pn; tab[F.lane * 8 + 4] = rtl; }
        const int n = __popcll(__ballot(ok)); if (F.lane == 0) tab[pg8::UT_MAXU * 8] = n;
    }
    __syncthreads();
    const int n = tab[pg8::UT_MAXU * 8];
    if (mode) {
        for (int base = F.tid; base < n * 256; base += 4 * NWAVES * 64) {
            int v[4]; bool in[4];
#pragma unroll
            for (int q = 0; q < 4; ++q) { const int idx = min(base + q * NWAVES * 64, n * 256 - 1), ui = idx >> 8, r = idx & 255, e = tab[ui * 8 + 2], pos = tab[ui * 8 + 4] * 256 + r;
                const int c = S.cnt[e * CNT_STRIDE]; in[q] = pos < c; v[q] = list[(size_t)e * T_TOK + (in[q] ? pos : 0)]; }
#pragma unroll
            for (int q = 0; q < 4; ++q) { const int idx = base + q * NWAVES * 64; if (idx < n * 256) toks[idx] = mode == 1 ? (in[q] ? (v[q] >> 2) : 0) : (in[q] ? v[q] : -1); }
        }
        __syncthreads();
    }
    return n;
}
constexpr int ML = 256, MUNITS = 512;
constexpr int KT_PITCH = 264;
constexpr int KR_PITCH = 136;
constexpr int P2_KT = 0, P2_VT = 67584, P2_SC = 135168;
constexpr int P4_K = 0, P4_VT = 69632, P4_SC = 137216;
constexpr float LOG2E = 1.4426950408889634f;
typedef unsigned u32x2v __attribute__((ext_vector_type(2)));

__device__ __forceinline__ unsigned cvtpk(float lo, float hi) { typedef float f2v_ __attribute__((ext_vector_type(2))); typedef __bf16 b2v_ __attribute__((ext_vector_type(2)));
    const f2v_ v = {lo, hi}; return __builtin_bit_cast(unsigned, __builtin_convertvector(v, b2v_)); }
__device__ __forceinline__ float bflo(unsigned u) { return __uint_as_float(u << 16); }
__device__ __forceinline__ float bfhi(unsigned u) { return __uint_as_float(u & 0xffff0000u); }
__device__ __forceinline__ int kpos(int key) { return (key & ~12) | ((key & 4) << 1) | ((key & 8) >> 1); }

__device__ __forceinline__ void stage_vt(const bf16_t* V, size_t row0, int col0, LAS unsigned char* vt, int tid) {
    const int rg = tid >> 4, cg = tid & 15;
    v4u rows[8];
#pragma unroll
    for (int r = 0; r < 8; ++r) rows[r] = *(const v4u*)(V + (row0 + rg * 8 + r) * 512 + col0 + cg * 8);
    const int g = rg >> 1, a = rg & 1;
#pragma unroll
    for (int e = 0; e < 8; ++e) {
        unsigned short x[8];
#pragma unroll
        for (int r = 0; r < 8; ++r) { const unsigned w = rows[r][e >> 1]; x[r] = (e & 1) ? (unsigned short)(w >> 16) : (unsigned short)(w & 0xffffu); }
        LAS unsigned char* p = vt + (cg * 8 + e) * (KT_PITCH * 2); const int b1 = (16 * g + 4 * a) * 2, sw = (cg & 15) << 4;
        *(LAS u32x2v*)(p + (b1 ^ sw)) = (u32x2v){(unsigned)x[0] | ((unsigned)x[1] << 16), (unsigned)x[2] | ((unsigned)x[3] << 16)};
        *(LAS u32x2v*)(p + ((b1 + 16) ^ sw)) = (u32x2v){(unsigned)x[4] | ((unsigned)x[5] << 16), (unsigned)x[6] | ((unsigned)x[7] << 16)};
    }
}

struct MlstmBufs { const bf16_t *MQ, *MK, *MV, *MO; const float* gates; const float *cw, *cb, *hw; bf16_t *MQc, *MKc; float* G; bf16_t* Cst; float *AB, *NV, *NST, *DC; bf16_t* Ym; };

__device__ __forceinline__ void mlstm_p2_unit(const Frame& F, const MlstmBufs& M, int u) {
    const int b = u >> 6, h = (u >> 4) & 3, c = u & 15, tid = F.tid;
    const size_t row0 = (size_t)b * SEQ + c * ML;
    LAS float* sA = (LAS float*)(F.lds + P2_SC); LAS float* sB = sA + 256; LAS float* sW = sA + 512; LAS float* sNV = sA + 1024; LAS float* sX = sA + 896;
    float fc = 0.f, ip = 0.f;
    if (tid < 256) {
        ip = M.gates[(row0 + tid) * 8 + h]; const float fp = M.gates[(row0 + tid) * 8 + 4 + h];
        fc = -log1pf(__expf(-fp));
#pragma unroll
        for (int o = 1; o < 64; o <<= 1) { const float t = __shfl_up(fc, o); if (F.lane >= o) fc += t; }
        if (F.lane == 63) sX[F.wave] = fc;
    }
    __syncthreads();
    if (tid < 256) {
        float off = 0.f;
#pragma unroll
        for (int w = 0; w < 4; ++w) if (w < F.wave) off += sX[w];
        fc += off;
        const float fend = sX[0] + sX[1] + sX[2] + sX[3];
        const float A = fc * LOG2E, B = (fc - ip) * LOG2E;
        sA[tid] = A; sB[tid] = B; sW[tid] = __expf(fend - fc + ip);
        *(float2*)(M.AB + ((row0 + tid) * 4 + h) * 2) = make_float2(A, B);
        if (tid == 0) M.DC[u] = __expf(fend);
    }
    __syncthreads();
    const int rg = tid >> 4, cg = tid & 15, ch0 = h * 128 + cg * 8;
    const int g = rg >> 1, a = rg & 1;
#pragma unroll
    for (int isk = 0; isk < 2; ++isk) {
        const bf16_t* src = isk ? M.MK : M.MQ; bf16_t* dst = isk ? M.MKc : M.MQc;
        float w[4][8], bias[8];
#pragma unroll
        for (int j = 0; j < 4; ++j) { const float4 p = *(const float4*)(M.cw + j * 1024 + isk * 512 + ch0), q = *(const float4*)(M.cw + j * 1024 + isk * 512 + ch0 + 4);
            w[j][0] = p.x; w[j][1] = p.y; w[j][2] = p.z; w[j][3] = p.w; w[j][4] = q.x; w[j][5] = q.y; w[j][6] = q.z; w[j][7] = q.w; }
        { const float4 p = *(const float4*)(M.cb + isk * 512 + ch0), q = *(const float4*)(M.cb + isk * 512 + ch0 + 4);
            bias[0] = p.x; bias[1] = p.y; bias[2] = p.z; bias[3] = p.w; bias[4] = q.x; bias[5] = q.y; bias[6] = q.z; bias[7] = q.w; }
        v4u raw[11];
#pragma unroll
        for (int i = 0; i < 11; ++i) { const int s = c * ML + rg * 8 - 3 + i;
            raw[i] = (s >= 0) ? *(const v4u*)(src + ((size_t)b * SEQ + s) * 512 + ch0) : (v4u){0u, 0u, 0u, 0u}; }
        float nvp[8];
#pragma unroll
        for (int e = 0; e < 8; ++e) nvp[e] = 0.f;
        unsigned ktp[8][4];
#pragma unroll
        for (int rp = 0; rp < 4; ++rp) {
            float kw[2][8];
#pragma unroll
            for (int rr = 0; rr < 2; ++rr) {
                const int r = 2 * rp + rr;
                float y[8];
#pragma unroll
                for (int e = 0; e < 8; ++e) { float s = bias[e];
#pragma unroll
                    for (int j = 0; j < 4; ++j) { const unsigned wd = raw[r + j][e >> 1]; s += w[j][e] * ((e & 1) ? bfhi(wd) : bflo(wd)); }
                    s = s * __builtin_amdgcn_rcpf(1.f + __expf(-s)); y[e] = isk ? s * 0.08838834764831845f : s; }
                v4u o; o.x = cvtpk(y[0], y[1]); o.y = cvtpk(y[2], y[3]); o.z = cvtpk(y[4], y[5]); o.w = cvtpk(y[6], y[7]);
                *(v4u*)(dst + (row0 + rg * 8 + r) * 512 + ch0) = o;
                if (isk) { const float ws = sW[rg * 8 + r];
#pragma unroll
                    for (int e = 0; e < 8; ++e) { kw[rr][e] = y[e] * ws; nvp[e] += kw[rr][e]; } }
            }
            if (isk) {
#pragma unroll
                for (int e = 0; e < 8; ++e) ktp[e][rp] = cvtpk(kw[0][e], kw[1][e]);
            }
        }
        if (isk) {
#pragma unroll
            for (int e = 0; e < 8; ++e) {
                LAS unsigned char* p = F.lds + P2_KT + (cg * 8 + e) * (KT_PITCH * 2); const int b1 = (16 * g + 4 * a) * 2, sw = (cg & 15) << 4;
                *(LAS u32x2v*)(p + (b1 ^ sw)) = (u32x2v){ktp[e][0], ktp[e][1]};
                *(LAS u32x2v*)(p + ((b1 + 16) ^ sw)) = (u32x2v){ktp[e][2], ktp[e][3]};
            }
#pragma unroll
            for (int e = 0; e < 8; ++e) { float t = nvp[e]; t += __shfl_xor(t, 16); t += __shfl_xor(t, 32); if (F.lane < 16) sNV[F.wave * 128 + cg * 8 + e] = t; }
        }
    }
    stage_vt(M.MV, row0, h * 128, F.lds + P2_VT, tid);
    __syncthreads();
    {
        const int r32 = F.lane & 31, hi = F.lane >> 5, mb = F.wave & 3, nb0 = 2 * (F.wave >> 2);
        f32x16 acc0 = f32x16{}, acc1 = f32x16{};
        const LAS unsigned char* pa = F.lds + P2_VT + (32 * mb + r32) * (KT_PITCH * 2);
        const LAS unsigned char* pb0 = F.lds + P2_KT + (32 * nb0 + r32) * (KT_PITCH * 2);
        const LAS unsigned char* pb1 = pb0 + 32 * (KT_PITCH * 2);
        const int swa = ((4 * mb + (r32 >> 3)) & 15) << 4, swb0 = ((4 * nb0 + (r32 >> 3)) & 15) << 4, swb1 = ((4 * nb0 + 4 + (r32 >> 3)) & 15) << 4;
#pragma unroll 4
        for (int ks = 0; ks < 16; ++ks) {
            const int o = ks * 32 + hi * 16;
            const bf16x8 av = *(const LAS bf16x8*)(pa + (o ^ swa)), b0 = *(const LAS bf16x8*)(pb0 + (o ^ swb0)), b1 = *(const LAS bf16x8*)(pb1 + (o ^ swb1));
            acc0 = __builtin_amdgcn_mfma_f32_32x32x16_bf16(av, b0, acc0, 0, 0, 0);
            acc1 = __builtin_amdgcn_mfma_f32_32x32x16_bf16(av, b1, acc1, 0, 0, 0);
        }
        float* Gu = M.G + (size_t)u * 16384;
#pragma unroll
        for (int rg2 = 0; rg2 < 16; ++rg2) { const int dv = 32 * mb + crow(rg2, hi);
            Gu[dv * 128 + 32 * nb0 + r32] = acc0[rg2]; Gu[dv * 128 + 32 * nb0 + 32 + r32] = acc1[rg2]; }
    }
    if (tid < 128) { float s = 0.f;
#pragma unroll
        for (int w = 0; w < 8; ++w) s += sNV[w * 128 + tid];
        M.NV[(size_t)u * 128 + tid] = s; }
    __syncthreads();
}

__device__ __forceinline__ void mlstm_scan_slice(const Frame& F, const MlstmBufs& M, int sidx) {
    const int bh = sidx >> 3, sl = sidx & 7, tid = F.tid;
    const int dv = 16 * sl + (tid >> 5), dk = (tid & 31) * 4;
    f32x4v g[16]; float dc[16], nv[16];
    const bool nrow = sl == 0 && tid < 128;
#pragma unroll
    for (int c = 0; c < 16; ++c) { g[c] = *(const f32x4v*)(M.G + (size_t)(bh * 16 + c) * 16384 + dv * 128 + dk); dc[c] = M.DC[bh * 16 + c];
        nv[c] = M.NV[(size_t)(bh * 16 + c) * 128 + (tid & 127)]; }
    f32x4v C = {0.f, 0.f, 0.f, 0.f};
#pragma unroll
    for (int c = 0; c < 16; ++c) {
        const int u = bh * 16 + c;
        *(uint2*)(M.Cst + (size_t)u * 16384 + dv * 128 + dk) = make_uint2(cvtpk(C[0], C[1]), cvtpk(C[2], C[3]));
        C = C * dc[c] + g[c];
    }
    if (nrow) {
        float n = 0.f;
#pragma unroll
        for (int c = 0; c < 16; ++c) { const int u = bh * 16 + c; M.NST[(size_t)u * 128 + tid] = n; n = n * dc[c] + nv[c]; }
    }
}

__device__ __forceinline__ void mlstm_p4_unit(const Frame& F, const MlstmBufs& M, int u) {
    const int b = u >> 6, h = (u >> 4) & 3, c = u & 15, tid = F.tid;
    const size_t row0 = (size_t)b * SEQ + c * ML;
    LAS float* sA = (LAS float*)(F.lds + P4_SC); LAS float* sB = sA + 256; LAS float* sN = sA + 512; LAS float* sH = sA + 640;
    if (tid < 256) { const float2 ab = *(const float2*)(M.AB + ((row0 + tid) * 4 + h) * 2); sA[tid] = ab.x; sB[tid] = ab.y; }
    else { int tq = tid; asm volatile("" : "+v"(tq));
        if (tq < 384) sN[tq - 256] = M.NST[(size_t)u * 128 + tq - 256];
        else sH[tq - 384] = M.hw[h * 128 + tq - 384]; }
#pragma unroll
    for (int i = 0; i < 8; ++i) { const int idx = tid + 512 * i, row = idx >> 4, seg = idx & 15;
        const v4u v = *(const v4u*)(M.MKc + (row0 + row) * 512 + h * 128 + seg * 8);
        *(LAS v4u*)(F.lds + P4_K + row * (KR_PITCH * 2) + seg * 16) = v; }
    stage_vt(M.MV, row0, h * 128, F.lds + P4_VT, tid);
    __syncthreads();
    const int w = F.wave < 4 ? F.wave : 11 - F.wave, r32 = F.lane & 31, hi = F.lane >> 5;
    const size_t trow = row0 + 32 * w + r32;
    bf16x8 qr[8];
#pragma unroll
    for (int ks = 0; ks < 8; ++ks) qr[ks] = *(const bf16x8*)(M.MQc + trow * 512 + h * 128 + 16 * ks + 8 * hi);
    const float Aq = sA[32 * w + r32], at = __builtin_amdgcn_exp2f(Aq);
    f32x16 o[4];
    const bf16_t* Cu = M.Cst + (size_t)u * 16384;
#pragma unroll
    for (int mb = 0; mb < 4; ++mb) {
        o[mb] = f32x16{};
#pragma unroll
        for (int ks = 0; ks < 8; ++ks) { const bf16x8 cf = *(const bf16x8*)(Cu + (32 * mb + r32) * 128 + 16 * ks + 8 * hi);
            o[mb] = __builtin_amdgcn_mfma_f32_32x32x16_bf16(cf, qr[ks], o[mb], 0, 0, 0); }
#pragma unroll
        for (int r = 0; r < 16; ++r) o[mb][r] *= at;
    }
    float den = 0.f;
#pragma unroll
    for (int ks = 0; ks < 8; ++ks) { const f32x4v n0 = *(const LAS f32x4v*)(sN + 16 * ks + 8 * hi), n1 = *(const LAS f32x4v*)(sN + 16 * ks + 8 * hi + 4);
#pragma unroll
        for (int j = 0; j < 4; ++j) { den += n0[j] * bf2f((unsigned short)qr[ks][j]); den += n1[j] * bf2f((unsigned short)qr[ks][4 + j]); } }
    den *= at;
    for (int kb = 0; kb <= w; ++kb) {
        f32x16 st = f32x16{};
        const LAS unsigned char* kp = F.lds + P4_K + (32 * kb + r32) * (KR_PITCH * 2) + hi * 16;
#pragma unroll
        for (int ks = 0; ks < 8; ++ks) { const bf16x8 kf = *(const LAS bf16x8*)(kp + ks * 32); st = __builtin_amdgcn_mfma_f32_32x32x16_bf16(kf, qr[ks], st, 0, 0, 0); }
        const bool diag = (kb == w);
#pragma unroll
        for (int g4 = 0; g4 < 4; ++g4) { const f32x4v bk = *(const LAS f32x4v*)(sB + 32 * kb + 8 * g4 + 4 * hi);
#pragma unroll
            for (int e = 0; e < 4; ++e) { const int r = 4 * g4 + e; float p = st[r] * __builtin_amdgcn_exp2f(Aq - bk[e]);
                if (diag && (8 * g4 + 4 * hi + e) > r32) p = 0.f;
                st[r] = p; den += p; } }
        bf16x8 pf[2];
#pragma unroll
        for (int s2 = 0; s2 < 2; ++s2) { v4u t; t.x = cvtpk(st[8 * s2], st[8 * s2 + 1]); t.y = cvtpk(st[8 * s2 + 2], st[8 * s2 + 3]); t.z = cvtpk(st[8 * s2 + 4], st[8 * s2 + 5]); t.w = cvtpk(st[8 * s2 + 6], st[8 * s2 + 7]);
            pf[s2] = __builtin_bit_cast(bf16x8, t); }
#pragma unroll
        for (int mb = 0; mb < 4; ++mb)
#pragma unroll
            for (int s2 = 0; s2 < 2; ++s2) { const bf16x8 vf = *(const LAS bf16x8*)(F.lds + P4_VT + (32 * mb + r32) * (KT_PITCH * 2) + (((32 * kb + 16 * s2 + 8 * hi) * 2) ^ (((4 * mb + (r32 >> 3)) & 15) << 4)));
                o[mb] = __builtin_amdgcn_mfma_f32_32x32x16_bf16(vf, pf[s2], o[mb], 0, 0, 0); }
    }
    { auto rr = __builtin_amdgcn_permlane32_swap(__float_as_uint(den), __float_as_uint(den), false, false); den = __uint_as_float(rr[0]) + __uint_as_float(rr[1]); }
    const float dinv = 1.f / fmaxf(fabsf(den), 1.f);
    float ss = 0.f;
#pragma unroll
    for (int mb = 0; mb < 4; ++mb)
#pragma unroll
        for (int r = 0; r < 16; ++r) { o[mb][r] *= dinv; ss += o[mb][r] * o[mb][r]; }
    { auto rr = __builtin_amdgcn_permlane32_swap(__float_as_uint(ss), __float_as_uint(ss), false, false); ss = __uint_as_float(rr[0]) + __uint_as_float(rr[1]); }
    const float rs = rsqrtf(ss * (1.f / 128.f) + EPS);
    {
        LAS unsigned char* stg = F.lds + P4_SC + 3072 + F.wave * 2560;
        const int srow = F.lane >> 2, sseg = F.lane & 3;
        const size_t grow = (row0 + 32 * w + srow) * 512 + h * 128 + 8 * sseg;
        v4u moin[4][2];
#pragma unroll
        for (int mb = 0; mb < 4; ++mb)
#pragma unroll
            for (int p = 0; p < 2; ++p) moin[mb][p] = *(const v4u*)(M.MO + grow + (size_t)(16 * p) * 512 + 32 * mb);
#pragma unroll
        for (int mb = 0; mb < 4; ++mb) {
#pragma unroll
            for (int p = 0; p < 2; ++p) *(LAS v4u*)(stg + (16 * p + srow) * 80 + sseg * 16) = moin[mb][p];
            asm volatile("s_waitcnt lgkmcnt(0)" ::: "memory");
            u32x2v yv[4];
#pragma unroll
            for (int g4 = 0; g4 < 4; ++g4) { const int dvl = 8 * g4 + 4 * hi, dv = 32 * mb + dvl;
                const u32x2v mo = *(const LAS u32x2v*)(stg + r32 * 80 + dvl * 2);
                const f32x4v hw = *(const LAS f32x4v*)(sH + dv);
                const float y0 = o[mb][4 * g4] * rs * hw[0] * bflo(mo.x), y1 = o[mb][4 * g4 + 1] * rs * hw[1] * bfhi(mo.x);
                const float y2 = o[mb][4 * g4 + 2] * rs * hw[2] * bflo(mo.y), y3 = o[mb][4 * g4 + 3] * rs * hw[3] * bfhi(mo.y);
                yv[g4] = (u32x2v){cvtpk(y0, y1), cvtpk(y2, y3)}; }
            asm volatile("s_waitcnt lgkmcnt(0)" ::: "memory");
#pragma unroll
            for (int g4 = 0; g4 < 4; ++g4) *(LAS u32x2v*)(stg + r32 * 80 + (8 * g4 + 4 * hi) * 2) = yv[g4];
            asm volatile("s_waitcnt lgkmcnt(0)" ::: "memory");
#pragma unroll
            for (int p = 0; p < 2; ++p) { const v4u t = *(const LAS v4u*)(stg + (16 * p + srow) * 80 + sseg * 16);
                *(v4u*)(M.Ym + grow + (size_t)(16 * p) * 512 + 32 * mb) = t; }
            asm volatile("s_waitcnt lgkmcnt(0)" ::: "memory");
        }
    }
    __syncthreads();
}
#ifndef REPMASK
#define REPMASK 0
#endif
__global__ void __launch_bounds__(NWAVES * 64, 2) mega(MArgs a) {
    extern __shared__ __attribute__((aligned(16))) unsigned char lds_raw[];
    Frame F;
    F.lds = (LAS unsigned char*)lds_raw;
    volatile LAS unsigned* MISC = (volatile LAS unsigned*)(F.lds + MISC_OFF);
    F.tid = threadIdx.x; F.lane = F.tid & 63; F.wave = __builtin_amdgcn_readfirstlane(F.tid >> 6);
    F.G = gridDim.x; { const int bx = blockIdx.x; F.vcu = (F.G % 8 == 0) ? (bx % 8) * (F.G / 8) + bx / 8 : bx; }
    unsigned char* ws = a.ws;
    int* ctl = (int*)(ws + WS_CTL * MiB);
    if (F.tid < 256) ((LAS unsigned*)(F.lds + MISC_OFF))[F.tid] = 0u;
    __syncthreads();
    XcdBarrier bar = xcd_barrier_post((unsigned*)(ctl + CW_BAR) + a.bar_region * XCD_BAR_WORDS, MISC + 8);
    const int lo = a.ph_lo, hi = a.ph_hi;
#define IN(k) (lo <= (k) && (k) < hi)
#define BOTH(k) (IN(k) && IN((k) + 1))
    if (IN(0)) _Pragma("unroll") for (int rep_ = 0; rep_ <= ((REPMASK >> 0) & 1); ++rep_) { p0_prologue(F, a); if (BOTH(0) || rep_ < ((REPMASK >> 0) & 1)) xcd_barrier(bar); }
    if (IN(1)) _Pragma("unroll") for (int rep_ = 0; rep_ <= ((REPMASK >> 1) & 1); ++rep_) {
        pg8::Gemm g{(const bf16_t*)(ws + WS_XN * MiB), (const bf16_t*)(ws + WS_WIN * MiB), T_TOK, TIN, 1024};
        pg8::StaticOrder S; S.init(T_TOK, TIN, F.G, (int)blockIdx.x);
        pg8::EpiProj E{ws + WS_Q * MiB, (const float2*)(ws + WS_ROPE * MiB), (float*)(ws + WS_KMP * MiB)};
        const int grp = (blockIdx.x >> 3) & 7;
        const int trig = grp == 0 ? 0 : (grp == 7 ? 1 << 30 : (grp * 3 + 1) / 2);
        if (grp == 0) p0_fp8_weights(F, a);
        HookOrder SH; SH.init(T_TOK, TIN, F.G, (int)blockIdx.x); SH.F = &F; SH.a = &a; SH.trigger = trig; SH.count = 0;
        pg8::gemm_phase<pg8::EpiProj, HookOrder, true, true>(F.lds, g, SH, E);
        if (grp == 7 || SH.count < trig) p0_fp8_weights(F, a);
        if (BOTH(1) || rep_ < ((REPMASK >> 1) & 1)) xcd_barrier(bar);
    }
    MlstmBufs MB{(const bf16_t*)(ws + WS_MQ * MiB), (const bf16_t*)(ws + WS_MK * MiB), (const bf16_t*)(ws + WS_MV * MiB), (const bf16_t*)(ws + WS_MO * MiB),
                 (const float*)(ws + WS_GATES * MiB), a.in[3], a.in[4], a.in[6], (bf16_t*)(ws + WS_MQC * MiB), (bf16_t*)(ws + WS_MKC * MiB),
                 (float*)(ws + WS_G * MiB), (bf16_t*)(ws + WS_CST * MiB), (float*)(ws + WS_AB * MiB), (float*)(ws + WS_NV * MiB), (float*)(ws + WS_NST * MiB), (float*)(ws + WS_DC * MiB),
                 (bf16_t*)(ws + WS_YM * MiB)};
    if (IN(2)) _Pragma("unroll") for (int rep_ = 0; rep_ <= ((REPMASK >> 2) & 1); ++rep_) {
        for (int u = F.vcu; u < MUNITS; u += F.G) mlstm_p2_unit(F, MB, u);
        if (BOTH(2) || rep_ < ((REPMASK >> 2) & 1)) xcd_barrier(bar);
    }
    if (IN(3)) _Pragma("unroll") for (int rep_ = 0; rep_ <= ((REPMASK >> 3) & 1); ++rep_) {
        for (int sidx = F.vcu; sidx < 256; sidx += F.G) mlstm_scan_slice(F, MB, sidx);
        if (a.flags & 1) {
            v4u* ya = (v4u*)(ws + WS_YA * MiB);
            for (size_t i = (size_t)blockIdx.x * 512 + F.tid; i < (size_t)T_TOK * 512 * 2 / 16; i += (size_t)F.G * 512) ya[i] = (v4u){0u, 0u, 0u, 0u};
        }
        if (!(a.flags & 1)) {
            __syncthreads();
            const attn_body::AttnTensors AT{(const attn_body::bf16*)(ws + WS_Q * MiB), (const attn_body::bf16*)(ws + WS_K * MiB), (const attn_body::bf16*)(ws + WS_V * MiB), (attn_body::bf16*)(ws + WS_YA * MiB), (const float*)(ws + WS_KMP * MiB)};
            const attn_body::StaticOrder SA((int)F.G, (int)blockIdx.x, (a.flags >> 2) & 1);
            attn_body::attn_phase<attn_body::StaticOrder>((char*)lds_raw, AT, SA);
        }
        if (BOTH(3) || rep_ < ((REPMASK >> 3) & 1)) xcd_barrier(bar);
    }
    if (IN(4)) _Pragma("unroll") for (int rep_ = 0; rep_ <= ((REPMASK >> 4) & 1); ++rep_) {
        for (int u = F.vcu; u < MUNITS; u += F.G) mlstm_p4_unit(F, MB, u);
        if (BOTH(4) || rep_ < ((REPMASK >> 4) & 1)) xcd_barrier(bar);
    }
    if (IN(5)) _Pragma("unroll") for (int rep_ = 0; rep_ <= ((REPMASK >> 5) & 1); ++rep_) {
        bf16_t* merged = (bf16_t*)(ws + WS_MERGED * MiB);
        { pg8::Gemm g{(const bf16_t*)(ws + WS_YM * MiB), (const bf16_t*)(ws + WS_WB * MiB) + (size_t)1024 * 512, T_TOK, 1024, 512};
          pg8::StaticOrder S; S.init(T_TOK, 1024, F.G, (int)blockIdx.x);
          pg8::EpiBranch<false> E{(const unsigned char*)(ws + WS_GM * MiB), merged, (bf16_t*)(ws + WS_Q * MiB)};
          pg8::gemm_phase<pg8::EpiBranch<false>, pg8::StaticOrder, true, true>(F.lds, g, S, E); }
        { pg8::Gemm g{(const bf16_t*)(ws + WS_YA * MiB), (const bf16_t*)(ws + WS_WB * MiB), T_TOK, 1024, 512};
          pg8::StaticOrder S; S.init(T_TOK, 1024, F.G, (int)blockIdx.x);
          pg8::EpiBranch<true> E{(const unsigned char*)(ws + WS_GA * MiB), merged, (bf16_t*)(ws + WS_Q * MiB)};
          pg8::gemm_phase<pg8::EpiBranch<true>, pg8::StaticOrder, true, true>(F.lds, g, S, E); }
        if (BOTH(5) || rep_ < ((REPMASK >> 5) & 1)) xcd_barrier(bar);
    }
    if (IN(6)) _Pragma("unroll") for (int rep_ = 0; rep_ <= ((REPMASK >> 6) & 1); ++rep_) {
        pg8::Gemm g{(const bf16_t*)(ws + WS_MERGED * MiB), (const bf16_t*)(ws + WS_WO * MiB), T_TOK, 1024, 1024};
        pg8::StaticOrder S; S.init(T_TOK, 1024, F.G, (int)blockIdx.x);
        pg8::EpiOutRes E{a.in[0], (bf16_t*)(ws + WS_H * MiB)};
        pg8::gemm_phase<pg8::EpiOutRes, pg8::StaticOrder, true, true>(F.lds, g, S, E);
        if (BOTH(6) || rep_ < ((REPMASK >> 6) & 1)) xcd_barrier(bar);
    }
    volatile LAS int* tp = (volatile LAS int*)(F.lds + MISC_OFF) + TP_OFF;
    int* cnt = ctl + CW_CNT;
    int* asg_e = (int*)(ws + WS_ASGE * MiB); int* asg_pos = (int*)(ws + WS_ASGP * MiB); float* asg_g = (float*)(ws + WS_ASGG * MiB); int* list = (int*)(ws + WS_LIST * MiB);
    if (IN(7)) _Pragma("unroll") for (int rep_ = 0; rep_ <= ((REPMASK >> 7) & 1); ++rep_) {
        LAS bf16_t* whi = (LAS bf16_t*)F.lds; LAS bf16_t* wlo = whi + 32 * WR_PITCH; LAS float* lgs = (LAS float*)(F.lds + 4 * 32 * WR_PITCH) + F.wave * 512;
        __syncthreads();
        LAS int* hist = (LAS int*)(F.lds + MISC_OFF) + 72; LAS int* hbase = hist + 32;
        for (int it = 0; it * F.G * NWAVES < T_TOK / 16; ++it) { const int bt = (it * F.G + F.vcu) * NWAVES + F.wave; const bool valid = bt < T_TOK / 16;
            Frame F7 = F; asm volatile("" : "+v"(F7.tid), "+v"(F7.lane));
            HRows R; if (valid) hrows_load(R, (const bf16_t*)(ws + WS_H * MiB), bt * 16, F7.lane);
            if (it == 0) { stage_wsplit_dense32(a.in[10], a.in[9], whi, wlo, F7.tid); __syncthreads(); }
            router_round_regs(F7, bt, valid, R, a.in[9], whi, wlo, lgs, hist, hbase, a.in[11], (unsigned char*)(ws + WS_XN * MiB), cnt, asg_e, asg_pos, asg_g, list); }
        if (BOTH(7) || rep_ < ((REPMASK >> 7) & 1)) xcd_barrier(bar);
        if (rep_ < ((REPMASK >> 7) & 1)) { if (blockIdx.x == 0 && F.tid < 32) cnt[F.tid * CNT_STRIDE] = 0; xcd_barrier(bar); }
    }
    if (IN(8)) _Pragma("unroll") for (int rep_ = 0; rep_ <= ((REPMASK >> 8) & 1); ++rep_) {
        moe_prefix(F, cnt, tp);
        pg8::Gemm g{(const bf16_t*)(ws + WS_XN * MiB), (const bf16_t*)(ws + WS_W1 * MiB), 0, 2048, MOE1_FP8 ? 512 : 1024};
        pg8::GroupedOrder S; S.init(tp[32], 8, F.G, (int)blockIdx.x, tp, list, cnt);
        pg8::EpiMlp1 E{a.in[13], (bf16_t*)(ws + WS_ACT * MiB)};
        const int nu = moe_build_tables(F, S, 1, list);
        if (nu >= 0) { pg8::TableOrder ST{(const volatile LAS int*)(F.lds + pg8::UT_OFF), (const volatile LAS int*)(F.lds + pg8::UT_TOK_OFF), nu};
            pg8::gemm_phase<pg8::EpiMlp1, pg8::TableOrder, true, true, true, MOE1_FP8>(F.lds, g, ST, E); }

        if (BOTH(8) || rep_ < ((REPMASK >> 8) & 1)) xcd_barrier(bar);
    }
    if (IN(9)) _Pragma("unroll") for (int rep_ = 0; rep_ <= ((REPMASK >> 9) & 1); ++rep_) {
        moe_prefix(F, cnt, tp);
        pg8::Gemm g{(const bf16_t*)(ws + WS_ACT * MiB), (const bf16_t*)(ws + WS_W2 * MiB), 0, 1024, MOE2_FP8 ? 512 : 1024};
        pg8::GroupedOrder S; S.init(tp[32], 4, F.G, (int)blockIdx.x, tp, MOE2_FP8 ? nullptr : list, cnt);
        pg8::EpiMlp2 E{a.in[15], (bf16_t*)(ws + WS_YROWS * MiB), (const volatile LAS int*)(F.lds + pg8::UT_TOK_OFF)};
        const int nu = moe_build_tables(F, S, 2, list);
        if (nu >= 0) { pg8::TableOrder ST{(const volatile LAS int*)(F.lds + pg8::UT_OFF), nullptr, nu};
            pg8::gemm_phase<pg8::EpiMlp2, pg8::TableOrder, true, true, MOE2_FP8, MOE2_FP8>(F.lds, g, ST, E); }

        if (BOTH(9) || rep_ < ((REPMASK >> 9) & 1)) xcd_barrier(bar);
    }
    if (IN(10)) _Pragma("unroll") for (int rep_ = 0; rep_ <= ((REPMASK >> 10) & 1); ++rep_) {
        moe_prefix(F, cnt, tp);
        float dscale = 1.f;
        if (a.flags & 2) { const float* dg = (const float*)(ctl + CW_DIAG); dscale = 1.f + sqrtf(dg[0] / fmaxf(dg[1], 1e-30f)) + sqrtf(dg[2] / fmaxf(dg[3], 1e-30f)); }
        const int gw = F.vcu * NWAVES + F.wave, NGW = F.G * NWAVES;
        f32x4v wfv[4];
#pragma unroll
        for (int q = 0; q < 4; ++q) wfv[q] = *(const f32x4v*)(a.in[16] + 256 * q + 4 * F.lane);
        for (int row = gw; row < T_TOK; row += NGW)
            if (pg8::Y_FP8) final_row_f8(row, F.lane, (const bf16_t*)(ws + WS_H * MiB), (const unsigned char*)(ws + WS_YROWS * MiB), asg_g, wfv, a.out, dscale, (LAS float*)F.lds + F.wave * 1024);
            else final_row(row, F.lane, (const bf16_t*)(ws + WS_H * MiB), (const bf16_t*)(ws + WS_YROWS * MiB), asg_g, a.in[16], a.out, dscale);
        if (rep_ < ((REPMASK >> 10) & 1)) xcd_barrier(bar);
    }
#undef IN
#undef BOTH
}
extern "C" void kernel_launch(void* const* d_in, const int* in_sizes, int n_in, void* d_out, int out_size, void* d_ws, size_t ws_size, hipStream_t stream) {
    static int grid = 0;
    if (grid == 0) {
        if (n_in != 17 || ws_size < WS_END * MiB || in_sizes[0] != T_TOK * DM || out_size != T_TOK * DM) { fprintf(stderr, "kernel_launch: unexpected n_in %d / ws %zu\n", n_in, ws_size); grid = -1; return; }
        int dev = 0, cus = 0, per_cu = 0;
        if (hipGetDevice(&dev) != hipSuccess || hipDeviceGetAttribute(&cus, hipDeviceAttributeMultiprocessorCount, dev) != hipSuccess) { grid = -1; return; }
        if (hipFuncSetAttribute((const void*)mega, hipFuncAttributeMaxDynamicSharedMemorySize, LDS_BYTES) != hipSuccess) { fprintf(stderr, "kernel_launch: hipFuncSetAttribute failed\n"); grid = -1; return; }
        if (hipOccupancyMaxActiveBlocksPerMultiprocessor(&per_cu, (const void*)mega, NWAVES * 64, LDS_BYTES) != hipSuccess || per_cu < 1) { fprintf(stderr, "kernel_launch: occupancy query says %d\n", per_cu); per_cu = 1; }
        (void)hipGetLastError();
        grid = cus;
        if (grid * pg8::UT_MAXU < (MAXROWS / 256) * 8) { fprintf(stderr, "kernel_launch: %d CUs: the per-workgroup MoE unit table (%d units) is sized for MI355X (256 CUs)\n", grid, pg8::UT_MAXU); grid = -1; return; }
    }
    if (grid < 0) return;
    (void)hipMemsetAsync(d_ws, 0, 65536, stream);
    MArgs ma{};
    for (int i = 0; i < 17; ++i) ma.in[i] = (const float*)d_in[i];
    ma.out = (float*)d_out; ma.ws = (unsigned char*)d_ws; ma.ph_lo = 0; ma.ph_hi = 11; ma.bar_region = 0; ma.flags = 0;
#ifdef PROBE_FLAGS
    ma.flags = PROBE_FLAGS;
#endif
    void* args[] = {&ma};
    hipError_t e = hipLaunchCooperativeKernel((const void*)mega, dim3(grid), dim3(NWAVES * 64), args, LDS_BYTES, stream);
    if (e != hipSuccess) fprintf(stderr, "cooperative launch failed: %s (grid %d)\n", hipGetErrorString(e), grid);
}
```
